# Optimizing an MI355X kernel written in HIP

```python
import jax, jax.numpy as jnp
from jax import lax
import numpy as np

D_MODEL = 1024
BATCH = 2
SEQ = 8192
DEPTH = 1
DEC_BATCH = 32
DEC_SEQ = 8
PAST_LEN = 8192
PAGE_SIZE = 128

D_CONV = D_MODEL // 2
CONV_WIDTH = 3
N_HEADS = 8
HEAD_DIM = 64
D_ATT = N_HEADS * HEAD_DIM
D_FF = 4 * D_MODEL
Q_BLOCK = 128
RMS_EPS = 1e-6
SB_BIAS_INIT = -8.0
SPLIT_POINTS = (D_CONV, 2 * D_CONV, 3 * D_CONV,
                3 * D_CONV + D_ATT, 3 * D_CONV + 2 * D_ATT, 3 * D_CONV + 3 * D_ATT,
                3 * D_CONV + 3 * D_ATT + D_MODEL)
D_IN = 3 * D_CONV + 3 * D_ATT + 2 * D_MODEL

kernel_name = "hybrid_shortconv_stickbreaking_step"


def rmsnorm(x, w):
    xf = x.astype(jnp.float32)
    y = xf * lax.rsqrt(jnp.mean(xf * xf, axis=-1, keepdims=True) + RMS_EPS)
    return (y * w.astype(jnp.float32)).astype(x.dtype)


def stick_breaking_block(q, k, v, bias, q_pos, k_pos):
    z = (jnp.einsum('bhqd,bhkd->bhqk', q, k).astype(jnp.float32) * (HEAD_DIM ** -0.5)
         + bias.astype(jnp.float32)[None, :, None, None])
    causal = k_pos[None, :] < q_pos[:, None]
    log_beta = jax.nn.log_sigmoid(z)
    log_stay = jnp.where(causal, log_beta - z, 0.0)
    log_after = lax.cumsum(log_stay, axis=3, reverse=True) - log_stay
    w = jnp.where(causal, jnp.exp(log_beta + log_after), 0.0)
    return jnp.einsum('bhqk,bhkd->bhqd', w.astype(v.dtype), v)


def sb_prompt(q, k, v, bias):
    B, S = q.shape[0], q.shape[1]
    nb = S // Q_BLOCK
    qb = q.reshape(B, nb, Q_BLOCK, N_HEADS, HEAD_DIM).transpose(1, 0, 3, 2, 4)
    kt = k.transpose(0, 2, 1, 3)
    vt = v.transpose(0, 2, 1, 3)
    k_pos = jnp.arange(S)

    def one_block(args):
        q_blk, i = args
        q_pos = i * Q_BLOCK + jnp.arange(Q_BLOCK)
        return stick_breaking_block(q_blk, kt, vt, bias, q_pos, k_pos)

    o = lax.map(one_block, (qb, jnp.arange(nb)))
    return o.transpose(1, 0, 3, 2, 4).reshape(B, S, D_ATT)


def sb_sample(q, k_new, v_new, k_past, v_past, bias):
    B, L = q.shape[0], q.shape[1]
    P = k_past.shape[1]
    kt = jnp.concatenate([k_past, k_new], axis=1).transpose(0, 2, 1, 3)
    vt = jnp.concatenate([v_past, v_new], axis=1).transpose(0, 2, 1, 3)
    q_pos = P + jnp.arange(L)
    k_pos = jnp.arange(P + L)
    o = stick_breaking_block(q.transpose(0, 2, 1, 3), kt, vt, bias, q_pos, k_pos)
    return o.transpose(0, 2, 1, 3).reshape(B, L, D_ATT)


def hybrid_layer(x, conv_prev, k_past, v_past, norm1_w, w_in, conv_w, w_proj_conv,
                 w_proj_attn, att_bias, w_out, norm2_w, w_up, w_down):
    B, L = x.shape[0], x.shape[1]
    h = rmsnorm(x, norm1_w)
    proj = h @ w_in
    b_g, c_g, u, q, k, v, gate_conv, gate_att = jnp.split(proj, SPLIT_POINTS, axis=-1)
    cu = c_g * u
    cu_full = jnp.concatenate([conv_prev, cu], axis=1)
    conv = sum(conv_w[j] * cu_full[:, j:j + L] for j in range(CONV_WIDTH))
    y_conv = (b_g * conv) @ w_proj_conv
    new_conv = cu_full[:, L:]
    q = q.reshape(B, L, N_HEADS, HEAD_DIM)
    k = k.reshape(B, L, N_HEADS, HEAD_DIM)
    v = v.reshape(B, L, N_HEADS, HEAD_DIM)
    if k_past is None:
        o = sb_prompt(q, k, v, att_bias)
    else:
        o = sb_sample(q, k, v, k_past, v_past, att_bias)
    y_att = o @ w_proj_attn
    merged = jax.nn.sigmoid(gate_conv) * y_conv + jax.nn.sigmoid(gate_att) * y_att
    x = x + merged @ w_out
    f = rmsnorm(x, norm2_w) @ w_up
    x = x + jnp.square(jax.nn.relu(f)) @ w_down
    return x, new_conv, k, v


def setup_inputs(seed: int = 0) -> dict:
    key = jax.random.key(seed)
    ks = jax.random.split(key, 20)
    n_pages = PAST_LEN // PAGE_SIZE
    n_used = DEC_BATCH * n_pages
    n_pool = n_used + n_used // 4
    f32 = jnp.float32
    x_prompt = jax.random.normal(ks[0], (BATCH, SEQ, D_MODEL), f32)
    x_sample = jax.random.normal(ks[1], (DEC_BATCH, DEC_SEQ, D_MODEL), f32)
    cache_k = jax.random.normal(ks[2], (DEPTH, n_pool, PAGE_SIZE, N_HEADS, HEAD_DIM), f32)
    cache_v = jax.random.normal(ks[3], (DEPTH, n_pool, PAGE_SIZE, N_HEADS, HEAD_DIM), f32)
    state_conv = jax.random.normal(ks[4], (DEPTH, DEC_BATCH, CONV_WIDTH - 1, D_CONV), f32)
    page_table = jax.random.permutation(ks[5], n_pool)[:n_used].astype(jnp.int32).reshape(DEC_BATCH, n_pages)
    norm1_w = 1.0 + 0.02 * jax.random.normal(ks[6], (DEPTH, D_MODEL), f32)
    w_in = jax.random.normal(ks[7], (DEPTH, D_MODEL, D_IN), f32) * D_MODEL ** -0.5
    conv_w = jax.random.normal(ks[8], (DEPTH, CONV_WIDTH, D_CONV), f32) * CONV_WIDTH ** -0.5
    w_proj_conv = jax.random.normal(ks[9], (DEPTH, D_CONV, D_MODEL), f32) * D_CONV ** -0.5
    w_proj_attn = jax.random.normal(ks[10], (DEPTH, D_ATT, D_MODEL), f32) * D_ATT ** -0.5
    att_bias = SB_BIAS_INIT + 0.1 * jax.random.normal(ks[16], (DEPTH, N_HEADS), f32)
    w_out = jax.random.normal(ks[11], (DEPTH, D_MODEL, D_MODEL), f32) * D_MODEL ** -0.5
    norm2_w = 1.0 + 0.02 * jax.random.normal(ks[12], (DEPTH, D_MODEL), f32)
    w_up = jax.random.normal(ks[13], (DEPTH, D_MODEL, D_FF), f32) * D_MODEL ** -0.5
    w_down = jax.random.normal(ks[14], (DEPTH, D_FF, D_MODEL), f32) * D_FF ** -0.5
    norm_f_w = 1.0 + 0.02 * jax.random.normal(ks[15], (D_MODEL,), f32)
    return {"x_prompt": x_prompt, "x_sample": x_sample, "cache_k": cache_k, "cache_v": cache_v,
            "state_conv": state_conv, "page_table": page_table, "norm1_w": norm1_w, "w_in": w_in,
            "conv_w": conv_w, "w_proj_conv": w_proj_conv, "w_proj_attn": w_proj_attn,
            "att_bias": att_bias, "w_out": w_out,
            "norm2_w": norm2_w, "w_up": w_up, "w_down": w_down, "norm_f_w": norm_f_w}


def reference(x_prompt, x_sample, cache_k, cache_v, state_conv, page_table, norm1_w, w_in,
              conv_w, w_proj_conv, w_proj_attn, att_bias, w_out, norm2_w, w_up, w_down, norm_f_w):
    Bp, S = x_prompt.shape[0], x_prompt.shape[1]
    Bd = x_sample.shape[0]
    n_pages = page_table.shape[1]
    xp, xs = x_prompt, x_sample
    kp_l, vp_l, cp_l, ks_l, vs_l, cs_l = [], [], [], [], [], []
    for l in range(DEPTH):
        w = (norm1_w[l], w_in[l], conv_w[l], w_proj_conv[l], w_proj_attn[l], att_bias[l],
             w_out[l], norm2_w[l], w_up[l], w_down[l])
        conv0 = jnp.zeros((Bp, CONV_WIDTH - 1, D_CONV), xp.dtype)
        xp, cp, kp, vp = hybrid_layer(xp, conv0, None, None, *w)
        kp_l.append(kp.reshape(Bp, S // PAGE_SIZE, PAGE_SIZE, N_HEADS, HEAD_DIM))
        vp_l.append(vp.reshape(Bp, S // PAGE_SIZE, PAGE_SIZE, N_HEADS, HEAD_DIM))
        cp_l.append(cp)
        k_past = cache_k[l][page_table].reshape(Bd, n_pages * PAGE_SIZE, N_HEADS, HEAD_DIM)
        v_past = cache_v[l][page_table].reshape(Bd, n_pages * PAGE_SIZE, N_HEADS, HEAD_DIM)
        xs, cs, kn, vn = hybrid_layer(xs, state_conv[l], k_past, v_past, *w)
        ks_l.append(kn)
        vs_l.append(vn)
        cs_l.append(cs)
    y_prompt = rmsnorm(xp, norm_f_w)
    y_sample = rmsnorm(xs, norm_f_w)
    return (y_prompt, y_sample, jnp.stack(kp_l), jnp.stack(vp_l), jnp.stack(cp_l),
            jnp.stack(ks_l), jnp.stack(vs_l), jnp.stack(cs_l))
```

```cpp
#include <hip/hip_runtime.h>
#include <cstdio>
#include <cstdint>
namespace pg8 {
#define PG8_LAS __attribute__((address_space(3)))
typedef unsigned short bf16_t;
typedef short bf16x8 __attribute__((ext_vector_type(8)));
typedef float f32x4 __attribute__((ext_vector_type(4)));
typedef unsigned u32x4 __attribute__((ext_vector_type(4)));
constexpr int BM = 256, BK = 64, HALF = 128, HTB = HALF * BK * 2  , STAGE_BYTES = 8 * HTB, NXCD = 8, WGM = 8;

__host__ __device__ __forceinline__ int lds_byte(int r, int c) { const int st = (r >> 4) * 2 + (c >> 5), rr = r & 15, cc = c & 31, ob = rr * 64 + cc * 2; return st * 1024 + (ob ^ (((ob >> 9) & 1) << 5)); }
__host__ __device__ __forceinline__ void stage_rc(int b, int& R, int& C) { const int st = b / 1024, sb = b % 1024, swz = sb ^ (((sb >> 9) & 1) << 5); R = (st >> 1) * 16 + swz / 64; C = (st & 1) * 32 + (swz % 64) / 2; }
__host__ __device__ __forceinline__ int perm32(int rho) { const int n = rho >> 4, i = rho & 15; return 8 * (i >> 2) + 4 * n + (i & 3); }

struct Unit { int pm, pn; };
struct Gemm { const bf16_t* A; const bf16_t* Bt; int M, N, K; };

struct StaticOrder {
    int nM, nN, nwg, G, c;
    __host__ __device__ void init(int M, int N, int G_, int c_) { nM = M / BM; nN = N / BM; nwg = nM * nN; G = G_; c = c_; }
    __host__ __device__ bool next(int i, Unit& u) const {
        const long L = (long)i * G + c; if (L >= nwg) return false;
        int wgid = (int)L; { const int q = nwg / NXCD, r = nwg % NXCD, xcd = wgid % NXCD, off = wgid / NXCD; wgid = (xcd < r ? xcd * (q + 1) : r * (q + 1) + (xcd - r) * q) + off; }
        const int nig = WGM * nN, gid = wgid / nig, fm = gid * WGM, gsz = (nM - fm) < WGM ? (nM - fm) : WGM;
        u.pm = fm + ((wgid % nig) % gsz); u.pn = (wgid % nig) / gsz; return true;
    }
    __device__ __forceinline__ void a_ready(const Unit&) const {}
    __device__ __forceinline__ void done(const Unit&) const {}
};

typedef float f32x2c_t __attribute__((ext_vector_type(2))); typedef __bf16 bf16x2c_t __attribute__((ext_vector_type(2)));
__device__ __forceinline__ unsigned cvt_pk_bf16(float lo, float hi) { f32x2c_t v = {lo, hi}; bf16x2c_t b = __builtin_convertvector(v, bf16x2c_t); return __builtin_bit_cast(unsigned, b); }
typedef float f32x2 __attribute__((ext_vector_type(2)));
typedef unsigned u32x2 __attribute__((ext_vector_type(2)));
constexpr int MP = 16384;
constexpr size_t OFF_Y = 0, OFF_KP = 17039360, OFF_VP = 25427968, OFF_CP = 33816576, OFF_KS = 33818624, OFF_VS = 33949696, OFF_CS = 34080768;
__device__ __forceinline__ u32x4 pack8(f32x4 a, f32x4 b) { u32x4 w; w.x = cvt_pk_bf16(a[0], a[1]); w.y = cvt_pk_bf16(a[2], a[3]); w.z = cvt_pk_bf16(b[0], b[1]); w.w = cvt_pk_bf16(b[2], b[3]); return w; }
__device__ __forceinline__ void unpack8(u32x4 w, f32x4& a, f32x4& b) {
    a[0] = __uint_as_float(w.x << 16); a[1] = __uint_as_float(w.x & 0xffff0000u); a[2] = __uint_as_float(w.y << 16); a[3] = __uint_as_float(w.y & 0xffff0000u);
    b[0] = __uint_as_float(w.z << 16); b[1] = __uint_as_float(w.z & 0xffff0000u); b[2] = __uint_as_float(w.w << 16); b[3] = __uint_as_float(w.w & 0xffff0000u); }
__device__ __forceinline__ float sigmoidf_fast(float x) { return __builtin_amdgcn_rcpf(1.0f + __builtin_amdgcn_exp2f(-1.4426950408889634f * x)); }
__device__ __forceinline__ f32x4 sig4(f32x4 v) { f32x4 r; r[0] = sigmoidf_fast(v[0]); r[1] = sigmoidf_fast(v[1]); r[2] = sigmoidf_fast(v[2]); r[3] = sigmoidf_fast(v[3]); return r; }

struct EpiProj {
    static constexpr bool PERM = true, AFTER_DRAIN = false;
    bf16_t *CU, *BG, *Q, *KB, *VB, *SGC, *SGA; float* out; float qscale;
    __device__ __forceinline__ void operator()(const f32x4 (&acc)[2][2][4][2], const Unit& u, int wr, int wc, int fr, int fq) const {
        const int row0 = u.pm * BM + wr * 64 + fr, c8 = wc * 32 + 8 * fq, pn = u.pn;
        if (pn < 4) {
            const int j = pn * 128 + c8;
#pragma unroll
            for (int ai = 0; ai < 2; ++ai)
#pragma unroll
                for (int m = 0; m < 4; ++m) { const int row = row0 + ai * HALF + m * 16;
                    const f32x4 a0 = acc[ai][0][m][0] * acc[ai][1][m][0], a1 = acc[ai][0][m][1] * acc[ai][1][m][1];
                    *(u32x4*)(CU + (size_t)row * 512 + j) = pack8(a0, a1);
                    float* cs = nullptr;
                    if (row < MP) { const int t = row & 8191; if (t >= 8190) cs = out + OFF_CP + (size_t)(((row >> 13) * 2 + (t - 8190)) * 512 + j); }
                    else { const int r = row - MP, i = r & 7; if (i >= 6) cs = out + OFF_CS + (size_t)(((r >> 3) * 2 + (i - 6)) * 512 + j); }
                    if (cs) { *(f32x4*)cs = a0; *(f32x4*)(cs + 4) = a1; } }
        } else if (pn < 12) {
            const int kind = (pn - 4) >> 1;
            bf16_t* dst = BG + (size_t)kind * (size_t)(18u << 19); const float sc = kind == 1 ? qscale : 1.0f;
            const int colb = ((pn - 4) & 1) * 256 + c8;
#pragma unroll
            for (int ai = 0; ai < 2; ++ai)
#pragma unroll
                for (int m = 0; m < 4; ++m) { const int row = row0 + ai * HALF + m * 16;
#pragma unroll
                    for (int bj = 0; bj < 2; ++bj) { const int col = colb + bj * HALF; const f32x4 v0 = acc[ai][bj][m][0] * sc, v1 = acc[ai][bj][m][1] * sc;
                        *(u32x4*)(dst + (size_t)row * 512 + col) = pack8(v0, v1);
                        if (kind >= 2) { float* o = out + (kind == 2 ? (row < MP ? OFF_KP : OFF_KS) : (row < MP ? OFF_VP : OFF_VS)) + (size_t)(row < MP ? row : row - MP) * 512 + col;
                            *(f32x4*)o = v0; *(f32x4*)(o + 4) = v1; } } }
        } else {
            bf16_t* dst = pn < 16 ? SGC : SGA; const int colb = ((pn - 12) & 3) * 256 + c8;
#pragma unroll
            for (int ai = 0; ai < 2; ++ai)
#pragma unroll
                for (int m = 0; m < 4; ++m) { const int row = row0 + ai * HALF + m * 16;
#pragma unroll
                    for (int bj = 0; bj < 2; ++bj) { const int col = colb + bj * HALF;
                        *(u32x4*)(dst + (size_t)row * 1024 + col) = pack8(sig4(acc[ai][bj][m][0]), sig4(acc[ai][bj][m][1])); } }
        }
    }
};
template <int MODE> struct EpiBf {
    static constexpr bool PERM = true, AFTER_DRAIN = false;
    bf16_t* O; int ldc; const bf16_t* G1; const bf16_t* ADD;
    __device__ __forceinline__ void operator()(const f32x4 (&acc)[2][2][4][2], const Unit& u, int wr, int wc, int fr, int fq) const {
        const int row0 = u.pm * BM + wr * 64 + fr, col0 = u.pn * BM + wc * 32 + 8 * fq;
#pragma unroll
        for (int ai = 0; ai < 2; ++ai)
#pragma unroll
            for (int m = 0; m < 4; ++m) { const size_t ro = (size_t)(row0 + ai * HALF + m * 16) * ldc + col0;
#pragma unroll
                for (int bj = 0; bj < 2; ++bj) { f32x4 v0 = acc[ai][bj][m][0], v1 = acc[ai][bj][m][1];
                    if (MODE == 0 || MODE == 1) { f32x4 g0, g1; unpack8(*(const u32x4*)(G1 + ro + bj * HALF), g0, g1); v0 = v0 * g0; v1 = v1 * g1; }
                    if (MODE == 1) { f32x4 t0, t1; unpack8(*(const u32x4*)(ADD + ro + bj * HALF), t0, t1); v0 = v0 + t0; v1 = v1 + t1; }
                    if (MODE == 2) { v0 = __builtin_elementwise_max(v0, (f32x4){0.f, 0.f, 0.f, 0.f}); v1 = __builtin_elementwise_max(v1, (f32x4){0.f, 0.f, 0.f, 0.f}); v0 = v0 * v0; v1 = v1 * v1; }
                    *(u32x4*)(O + ro + bj * HALF) = pack8(v0, v1); } }
    }
};
struct EpiResF32 {
    static constexpr bool PERM = false, AFTER_DRAIN = false;
    const float* base0; const float* base1; float* out;
    __device__ __forceinline__ void operator()(const f32x4 (&acc)[2][2][4][2], const Unit& u, int wr, int wc, int fr, int fq) const {
        const int row0 = u.pm * BM + wr * 64 + fr, col0 = u.pn * BM + wc * 32 + 4 * fq;
#pragma unroll
        for (int ai = 0; ai < 2; ++ai)
#pragma unroll
            for (int m = 0; m < 4; ++m) { const int row = row0 + ai * HALF + m * 16; const float* bp = (row < MP ? base0 + (size_t)row * 1024 : base1 + (size_t)(row - MP) * 1024) + col0; float* op = out + (size_t)row * 1024 + col0;
#pragma unroll
                for (int bj = 0; bj < 2; ++bj)
#pragma unroll
                    for (int n = 0; n < 2; ++n) *(f32x4*)(op + bj * HALF + n * 16) = *(const f32x4*)(bp + bj * HALF + n * 16) + acc[ai][bj][m][n]; }
    }
};
template <class Epi, class Sched, bool ALIGN_EPI = false, bool SP2 = false>
__device__ __forceinline__ void gemm_phase(PG8_LAS unsigned char* lds, const Gemm g, const Sched& S, const Epi& E) {
    const int tid = threadIdx.x, wid = __builtin_amdgcn_readfirstlane(tid >> 6), lane = tid & 63, wr = wid >> 2, wc = wid & 3, fr = lane & 15, fq = lane >> 4;
    const int K = g.K, nt = K / BK;
    unsigned voffA[2], voffB[2];
#pragma unroll
    for (int i = 0; i < 2; ++i) { int R, C; stage_rc(tid * 16 + i * 8192, R, C); const int Rb = Epi::PERM ? ((R & ~31) + perm32(R & 31)) : R;
        voffA[i] = (unsigned)(R * K + C) * 2u; voffB[i] = (unsigned)(Rb * K + C) * 2u; }
    const size_t kstep = (size_t)(BK * 2);
    const size_t hstep = (size_t)HALF * K * 2;
    const size_t tstep = 2 * hstep;
    const unsigned ldsw = (unsigned)wid * 1024u;
    const int aoff = lds_byte(wr * 64 + fr, fq * 8), boff = lds_byte(wc * 32 + fr, fq * 8);
#define PG8_SA(b, h) (((b) * 2 + (h)) * HTB)
#define PG8_SB(b, h) ((4 + (b) * 2 + (h)) * HTB)
#define PG8_STAGE(bufoff, gbase, voff) do { _Pragma("unroll") for (int _i = 0; _i < 2; ++_i) \
        __builtin_amdgcn_global_load_lds((const unsigned*)((const char*)(gbase) + (voff)[_i]), (PG8_LAS unsigned*)(lds + (bufoff) + ldsw + _i * 8192), 16, 0, 0); } while (0)
#define PG8_LDA(dst, b, h) do { _Pragma("unroll") for (int m = 0; m < 4; ++m) _Pragma("unroll") for (int k = 0; k < 2; ++k) dst[m][k] = *(const PG8_LAS bf16x8*)(lds + PG8_SA(b, h) + aoff + m * 2048 + k * 1024); } while (0)
#define PG8_LDB(dst, b, h) do { _Pragma("unroll") for (int n = 0; n < 2; ++n) _Pragma("unroll") for (int k = 0; k < 2; ++k) dst[n][k] = *(const PG8_LAS bf16x8*)(lds + PG8_SB(b, h) + boff + n * 2048 + k * 1024); } while (0)
#define PG8_MMA(ai, bj, At, Bt) do { __builtin_amdgcn_s_setprio(1); _Pragma("unroll") for (int m = 0; m < 4; ++m) _Pragma("unroll") for (int n = 0; n < 2; ++n) _Pragma("unroll") for (int k = 0; k < 2; ++k) \
        acc[ai][bj][m][n] = __builtin_amdgcn_mfma_f32_16x16x32_bf16(Bt[n][k], At[m][k], acc[ai][bj][m][n], 0, 0, 0); __builtin_amdgcn_s_setprio(0); } while (0)
#define PG8_WAIT_V(n) asm volatile("s_waitcnt vmcnt(" #n ")" ::: "memory")
#define PG8_WAIT_L(n) asm volatile("s_waitcnt lgkmcnt(" #n ")" ::: "memory")
#define PG8_BAR __builtin_amdgcn_s_barrier()
#define PG8_SCHED __builtin_amdgcn_sched_barrier(0)
    Unit cur, nxt; int ui = 0;
    if (!S.next(0, cur)) return;
    f32x4 acc[2][2][4][2];
#pragma unroll
    for (int a = 0; a < 2; ++a)
#pragma unroll
        for (int b = 0; b < 2; ++b)
#pragma unroll
            for (int m = 0; m < 4; ++m)
#pragma unroll
                for (int n = 0; n < 2; ++n) acc[a][b][m][n] = (f32x4){0.f, 0.f, 0.f, 0.f};
    bf16x8 At[4][2], B0[2][2], B1[2][2];
    const char* cA = (const char*)g.A + (size_t)cur.pm * tstep; const char* cB = (const char*)g.Bt + (size_t)cur.pn * tstep;
    S.a_ready(cur);
    if constexpr (SP2) {
        PG8_STAGE(PG8_SB(0, 0), cB, voffB); PG8_STAGE(PG8_SB(0, 1), cB + hstep, voffB); PG8_STAGE(PG8_SA(0, 0), cA, voffA); PG8_STAGE(PG8_SA(0, 1), cA + hstep, voffA);
        if (wr == 1) PG8_BAR;
        PG8_WAIT_V(2); PG8_BAR;
        PG8_STAGE(PG8_SB(1, 0), cB + kstep, voffB); PG8_STAGE(PG8_SA(1, 0), cA + kstep, voffA); PG8_STAGE(PG8_SB(1, 1), cB + hstep + kstep, voffB);
        PG8_WAIT_V(6); PG8_BAR;
    } else {
        PG8_STAGE(PG8_SB(0, 0), cB, voffB); PG8_STAGE(PG8_SA(0, 0), cA, voffA); PG8_STAGE(PG8_SB(0, 1), cB + hstep, voffB); PG8_STAGE(PG8_SA(0, 1), cA + hstep, voffA);
        if (wr == 1) PG8_BAR;
        PG8_WAIT_V(4); PG8_BAR;
        PG8_STAGE(PG8_SB(1, 0), cB + kstep, voffB); PG8_STAGE(PG8_SA(1, 0), cA + kstep, voffA); PG8_STAGE(PG8_SB(1, 1), cB + hstep + kstep, voffB);
        PG8_WAIT_V(6); PG8_BAR;
    }
    for (;;) {
        const bool has_next = S.next(ui + 1, nxt);
        const char* nA = has_next ? (const char*)g.A + (size_t)nxt.pm * tstep : cA; const char* nB = has_next ? (const char*)g.Bt + (size_t)nxt.pn * tstep : cB;
        for (int t = 0; t < nt; t += 2) {
            const bool last = (t == nt - 2);
            const char* a1 = cA + (size_t)(t + 1) * kstep;
            const char* a2 = last ? nA : cA + (size_t)(t + 2) * kstep; const char* b2 = last ? nB : cB + (size_t)(t + 2) * kstep;
            const char* a3 = a2 + kstep; const char* b3 = b2 + kstep;
            if (last && has_next) S.a_ready(nxt);
            if constexpr (SP2) {
            PG8_LDB(B0, 0, 0); PG8_LDB(B1, 0, 1); PG8_SCHED; PG8_LDA(At, 0, 0); PG8_STAGE(PG8_SA(1, 1), a1 + hstep, voffA);
            PG8_WAIT_V(8); PG8_WAIT_L(0); PG8_BAR; PG8_MMA(0, 0, At, B0); PG8_MMA(0, 1, At, B1); PG8_BAR; PG8_SCHED;
            PG8_LDA(At, 0, 1); PG8_STAGE(PG8_SB(0, 0), b2, voffB); PG8_STAGE(PG8_SB(0, 1), b2 + hstep, voffB); PG8_STAGE(PG8_SA(0, 0), a2, voffA);
            PG8_WAIT_V(8); PG8_WAIT_L(0); PG8_BAR; PG8_MMA(1, 0, At, B0); PG8_MMA(1, 1, At, B1); PG8_BAR; PG8_SCHED;
            PG8_LDB(B0, 1, 0); PG8_LDB(B1, 1, 1); PG8_SCHED; PG8_LDA(At, 1, 0); PG8_STAGE(PG8_SA(0, 1), a2 + hstep, voffA);
            PG8_WAIT_V(8); PG8_WAIT_L(0); PG8_BAR; PG8_MMA(0, 0, At, B0); PG8_MMA(0, 1, At, B1); PG8_BAR; PG8_SCHED;
            PG8_LDA(At, 1, 1); PG8_STAGE(PG8_SB(1, 0), b3, voffB); PG8_STAGE(PG8_SB(1, 1), b3 + hstep, voffB); PG8_STAGE(PG8_SA(1, 0), a3, voffA);
            PG8_WAIT_V(8); PG8_WAIT_L(0); PG8_BAR; PG8_MMA(1, 0, At, B0); PG8_MMA(1, 1, At, B1); PG8_BAR; PG8_SCHED;
            } else {
            PG8_LDB(B0, 0, 0); PG8_SCHED; PG8_LDA(At, 0, 0); PG8_STAGE(PG8_SA(1, 1), a1 + hstep, voffA);
            PG8_WAIT_L(8); PG8_BAR; PG8_WAIT_L(0); PG8_MMA(0, 0, At, B0); PG8_BAR; PG8_SCHED;
            PG8_LDB(B1, 0, 1); PG8_STAGE(PG8_SB(0, 0), b2, voffB);
            PG8_BAR; PG8_WAIT_L(0); PG8_MMA(0, 1, At, B1); PG8_BAR;
            PG8_LDA(At, 0, 1); PG8_STAGE(PG8_SA(0, 0), a2, voffA);
            PG8_BAR; PG8_WAIT_L(0); PG8_MMA(1, 0, At, B0); PG8_BAR; PG8_SCHED;
            PG8_STAGE(PG8_SB(0, 1), b2 + hstep, voffB);
            PG8_WAIT_V(6); PG8_BAR; PG8_MMA(1, 1, At, B1); PG8_BAR;
            PG8_LDB(B0, 1, 0); PG8_SCHED; PG8_LDA(At, 1, 0); PG8_STAGE(PG8_SA(0, 1), a2 + hstep, voffA);
            PG8_WAIT_L(8); PG8_BAR; PG8_WAIT_L(0); PG8_MMA(0, 0, At, B0); PG8_BAR; PG8_SCHED;
            PG8_LDB(B1, 1, 1); PG8_STAGE(PG8_SB(1, 0), b3, voffB);
            PG8_BAR; PG8_WAIT_L(0); PG8_MMA(0, 1, At, B1); PG8_BAR;
            PG8_LDA(At, 1, 1); PG8_STAGE(PG8_SA(1, 0), a3, voffA);
            PG8_BAR; PG8_WAIT_L(0); PG8_MMA(1, 0, At, B0); PG8_BAR; PG8_SCHED;
            PG8_STAGE(PG8_SB(1, 1), b3 + hstep, voffB);
            PG8_WAIT_V(6); PG8_BAR; PG8_MMA(1, 1, At, B1); PG8_BAR;
            }
        }
        if constexpr (ALIGN_EPI) { if (wr == 0) PG8_BAR; }
        if constexpr (!Epi::AFTER_DRAIN) { E(acc, cur, wr, wc, fr, fq); S.done(cur); }
        if (!has_next) break;
#pragma unroll
        for (int a = 0; a < 2; ++a)
#pragma unroll
            for (int b = 0; b < 2; ++b)
#pragma unroll
                for (int m = 0; m < 4; ++m)
#pragma unroll
                    for (int n = 0; n < 2; ++n) acc[a][b][m][n] = (f32x4){0.f, 0.f, 0.f, 0.f};
        cur = nxt; cA = nA; cB = nB; ++ui;
        if constexpr (ALIGN_EPI) { if (wr == 1) PG8_BAR; }
    }
    PG8_WAIT_V(0);
    if constexpr (!ALIGN_EPI) { if (wr == 0) PG8_BAR; }
    PG8_BAR;
    if constexpr (Epi::AFTER_DRAIN) { E.fused(acc, cur, wr, wc, fr, fq, lds, wid, lane); S.done(cur); }
#undef PG8_SA
#undef PG8_SB
#undef PG8_STAGE
#undef PG8_LDA
#undef PG8_LDB
#undef PG8_MMA
#undef PG8_WAIT_V
#undef PG8_WAIT_L
#undef PG8_BAR
#undef PG8_SCHED
}
}
#define GAS __attribute__((address_space(1)))
#define LAS __attribute__((address_space(3)))
typedef unsigned short bf16;
typedef unsigned v4u __attribute__((ext_vector_type(4)));
typedef float f32x4 __attribute__((ext_vector_type(4)));
typedef short bf16x8 __attribute__((ext_vector_type(8)));
typedef GAS unsigned gu32;
typedef GAS unsigned long long gu64;
#define RLX_AGENT __ATOMIC_RELAXED, __HIP_MEMORY_SCOPE_AGENT
#define LDS_WAIT() asm volatile("s_waitcnt lgkmcnt(0)" ::: "memory")
#define VM_WAIT() asm volatile("s_waitcnt vmcnt(0)" ::: "memory")
__device__ __forceinline__ unsigned long long rt() { return __builtin_amdgcn_s_memrealtime(); }
__device__ __forceinline__ unsigned f2bf(float f) { unsigned u = __builtin_bit_cast(unsigned, f); return (u + 0x7fffu + ((u >> 16) & 1u)) >> 16; }
__device__ __forceinline__ unsigned pk2(float lo, float hi) { return f2bf(lo) | (f2bf(hi) << 16); }
#define XB_TMO      128
#define XB_XCNT(j)  (256  + 64 * (j))
#define XB_XSUB(j)  (1280 + 64 * (j))
#define XB_XGEN(j)  (2304 + 64 * (j))
#define XB_TOP      3328
#define XB_TOPGEN   3392
#define XCD_BAR_WORDS 3456
#define XB_SPIN_CAP (1u << 24)

__device__ __forceinline__ unsigned xb_ld(unsigned* p)              { return __hip_atomic_load(p, __ATOMIC_RELAXED, __HIP_MEMORY_SCOPE_AGENT); }
__device__ __forceinline__ unsigned xb_add(unsigned* p, unsigned v) { return __hip_atomic_fetch_add(p, v, __ATOMIC_RELAXED, __HIP_MEMORY_SCOPE_AGENT); }
__device__ __forceinline__ unsigned xb_xcc_id() { return (unsigned)__builtin_amdgcn_s_getreg((3 << 11) | 20) & 0xFu; }
#define XB_SPIN(cond, bar) do { unsigned _sp = 0; while (cond) { __builtin_amdgcn_s_sleep(1); \
    if ((++_sp & 255u) == 0u) { if (xb_ld(&(bar)[XB_TMO])) break; if (_sp > XB_SPIN_CAP) { atomicAdd(&(bar)[XB_TMO], 1u); break; } } } } while (0)

struct XcdBarrier {
    unsigned* bar; unsigned x;
    volatile LAS unsigned* st;
};

__device__ __forceinline__ XcdBarrier xcd_barrier_post(unsigned* bar, volatile LAS unsigned* st) {
    XcdBarrier b; b.bar = bar; b.x = xb_xcc_id(); b.st = st;
    if (threadIdx.x == 0) (void)xb_add(&bar[XB_XCNT(b.x)], 1u);
    return b;
}
__device__ __forceinline__ void xcd_barrier_complete(unsigned* bar, unsigned x, unsigned& nloc, unsigned& nx) {
    const unsigned G = gridDim.x * gridDim.y * gridDim.z;
    unsigned sum, cnt, mine, sp = 0u;
    for (;;) {
        sum = 0u; cnt = 0u; mine = 0u;
#pragma unroll
        for (unsigned j = 0; j < 16; ++j) { const unsigned c = xb_ld(&bar[XB_XCNT(j)]); sum += c; cnt += (c > 0u) ? 1u : 0u; mine = (j == x) ? c : mine; }
        if (sum == G) break;
        __builtin_amdgcn_s_sleep(1);
        if ((++sp & 255u) == 0u) { if (xb_ld(&bar[XB_TMO])) break; if (sp > XB_SPIN_CAP) { atomicAdd(&bar[XB_TMO], 1u); break; } }
    }
    nloc = mine > 0u ? mine : 1u; nx = cnt > 0u ? cnt : 1u;
}

__device__ __forceinline__ void xcd_barrier(const XcdBarrier& b) {
    asm volatile("s_waitcnt vmcnt(0)" ::: "memory");
    __syncthreads();
    if (threadIdx.x == 0) {
        unsigned* bar = b.bar;
        __builtin_amdgcn_s_waitcnt(0);
        unsigned nloc = b.st[0], nx = b.st[1];
        if (nloc == 0u) { xcd_barrier_complete(bar, b.x, nloc, nx); b.st[0] = nloc; b.st[1] = nx; }
        const unsigned old = xb_add(&bar[XB_XSUB(b.x)], 1u);
        const unsigned gen = old / nloc;
        if (old + 1u == (gen + 1u) * nloc) {
            __builtin_amdgcn_fence(__ATOMIC_RELEASE, "agent");
            asm volatile("s_waitcnt vmcnt(0)" ::: "memory");
            const unsigned og = xb_add(&bar[XB_TOP], 1u);
            const unsigned tg = og / nx;
            if (og + 1u == (tg + 1u) * nx) xb_add(&bar[XB_TOPGEN], 1u);
            else XB_SPIN(xb_ld(&bar[XB_TOPGEN]) == tg, bar);
            __builtin_amdgcn_fence(__ATOMIC_ACQUIRE, "agent");
            xb_add(&bar[XB_XGEN(b.x)], 1u);
            asm volatile("s_waitcnt vmcnt(0)" ::: "memory");
        } else {
            XB_SPIN(xb_ld(&bar[XB_XGEN(b.x)]) == gen, bar);
            __builtin_amdgcn_fence(__ATOMIC_ACQUIRE, "agent");
            asm volatile("s_waitcnt vmcnt(0)" ::: "memory");
        }
    }
    __syncthreads();
}
constexpr int NWAVES = 8;
#ifndef GEMM_ALIGN
#define GEMM_ALIGN true
#endif
#ifndef GEMM_SP2
#define GEMM_SP2 true
#endif
constexpr int DM = 1024, SEQ = 8192, NB = 2, MP = NB * SEQ, DB = 32, DL = 8, MS = DB * DL, MT = MP + MS;
constexpr int DCONV = 512, NH = 8, HD = 64, DATT = 512, DFF = 4096, DIN = 5120, PAGE = 128, NPAGES = 64;
constexpr float RMS_EPS = 1e-6f, LOG2E = 1.4426950408889634f, C2 = 0.125f * LOG2E;
using pg8::OFF_Y; using pg8::OFF_KP; using pg8::OFF_VP; using pg8::OFF_CP; using pg8::OFF_KS; using pg8::OFF_VS; using pg8::OFF_CS;
constexpr size_t OUT_ELEMS = 34113536;

constexpr size_t MiB = 1u << 20;
constexpr size_t WS_CTL = 0, CTL_ZERO_BYTES = 1 * MiB;
constexpr size_t WS_WIN = 2 * MiB, WS_WPC = 12 * MiB, WS_WPA = 13 * MiB, WS_WOUT = 14 * MiB, WS_WUP = 16 * MiB, WS_WDN = 24 * MiB;
constexpr size_t WS_H = 32 * MiB;
constexpr size_t WS_CU = 66 * MiB;
constexpr size_t WS_BG = 84 * MiB;
constexpr size_t WS_Q = 102 * MiB, WS_K = 120 * MiB, WS_V = 138 * MiB;
constexpr size_t WS_SGC = 156 * MiB, WS_SGA = 190 * MiB;
constexpr size_t WS_BC = 224 * MiB;
constexpr size_t WS_O = 242 * MiB;
constexpr size_t WS_T1 = 260 * MiB;
constexpr size_t WS_MG = 294 * MiB;
constexpr size_t WS_X1 = 328 * MiB;
constexpr size_t WS_G = 394 * MiB;
constexpr size_t WS_PT = 526 * MiB;
constexpr size_t WS_PO = 527 * MiB;
constexpr size_t WS_END = 560 * MiB;
constexpr int CW_BAR = 4096;
static_assert(WS_Q - WS_BG == 18 * MiB && WS_K - WS_Q == 18 * MiB && WS_V - WS_K == 18 * MiB, "EpiProj addresses BG|Q|K|V by stride");

constexpr int RING_OFF = 0, RING_BYTES = 131072;
constexpr int LDSCTL_OFF = RING_BYTES, MISC_OFF = LDSCTL_OFF + 320;
constexpr int LDS_BYTES = 147456;

struct Args {
    const float *xp, *xs, *ck, *cv, *sc; const int* pt; const float *n1w, *win, *cw, *wpc, *wpa, *ab, *wout, *n2w, *wup, *wdn, *nfw;
    float* out; unsigned char* ws; int ph_lo, ph_hi;
};
struct Frame {
    LAS unsigned char* lds; volatile LAS unsigned* MISC; gu32* ctl;
    int tid, lane, wave, vcu, G;
};

__device__ __forceinline__ float wave_sum(float v) {
#pragma unroll
    for (int o = 1; o < 64; o <<= 1) v += __shfl_xor(v, o);
    return v;
}
__device__ __forceinline__ int win_src_col(int vc) {
    const int u = vc >> 8, r = vc & 255;
    if (u < 4) return (r < 128) ? 512 + 128 * u + r : 1024 + 128 * u + (r - 128);
    if (u < 6) return 256 * (u - 4) + r;
    if (u < 12) return 1536 + 256 * (u - 6) + r;
    return 3072 + 256 * (u - 12) + r;
}
__device__ __forceinline__ void transpose_item(const float* W, int K, int N, bf16* WT, LAS float* scr, int kb, int nb, int src_n0, int lane) {
    const int k0 = 64 * kb, n0 = 32 * nb;
#pragma unroll 8
    for (int i = 0; i < 32; ++i) { const int kk = 2 * i + (lane >> 5); scr[kk * 33 + (lane & 31)] = W[(size_t)(k0 + kk) * N + src_n0 + (lane & 31)]; }
    LDS_WAIT(); asm volatile("" ::: "memory");
    const int c = lane & 7;
#pragma unroll
    for (int j = 0; j < 4; ++j) { const int n = (lane >> 3) + 8 * j; const LAS float* s = scr + (8 * c) * 33 + n;
        v4u o; o.x = pk2(s[0 * 33], s[1 * 33]); o.y = pk2(s[2 * 33], s[3 * 33]); o.z = pk2(s[4 * 33], s[5 * 33]); o.w = pk2(s[6 * 33], s[7 * 33]);
        *(GAS v4u*)(WT + (size_t)(n0 + n) * K + k0 + 8 * c) = o; }
    LDS_WAIT(); asm volatile("" ::: "memory");
}
__device__ __forceinline__ void rms_row_to_bf16(int lane, const float* xrow, const float* w, bf16* orow) {
    const GAS f32x4* xr = (const GAS f32x4*)xrow + lane; const GAS f32x4* wr = (const GAS f32x4*)w + lane;
    f32x4 v[4]; float s = 0.f;
#pragma unroll
    for (int j = 0; j < 4; ++j) { v[j] = xr[64 * j]; s += (v[j].x * v[j].x + v[j].y * v[j].y) + (v[j].z * v[j].z + v[j].w * v[j].w); }
    const float rstd = 1.0f / sqrtf(wave_sum(s) * (1.f / DM) + RMS_EPS);
    GAS unsigned long long* o8 = (GAS unsigned long long*)orow + lane;
#pragma unroll
    for (int j = 0; j < 4; ++j) { const f32x4 g = wr[64 * j]; o8[64 * j] = (unsigned long long)pk2(v[j].x * rstd * g.x, v[j].y * rstd * g.y) | ((unsigned long long)pk2(v[j].z * rstd * g.z, v[j].w * rstd * g.w) << 32); }
}
__device__ __forceinline__ void rms_row_to_f32(int lane, const float* xrow, const float* w, float* orow, bool poison) {
    const GAS f32x4* xr = (const GAS f32x4*)xrow + lane; const GAS f32x4* wr = (const GAS f32x4*)w + lane;
    f32x4 v[4]; float s = 0.f;
#pragma unroll
    for (int j = 0; j < 4; ++j) { v[j] = xr[64 * j]; s += (v[j].x * v[j].x + v[j].y * v[j].y) + (v[j].z * v[j].z + v[j].w * v[j].w); }
    float rstd = 1.0f / sqrtf(wave_sum(s) * (1.f / DM) + RMS_EPS); if (poison) rstd = __builtin_nanf("");
    GAS f32x4* o = (GAS f32x4*)orow + lane;
#pragma unroll
    for (int j = 0; j < 4; ++j) { const f32x4 g = wr[64 * j]; o[64 * j] = v[j] * rstd * g; }
}
__device__ __forceinline__ float bf2f(unsigned short b) { return __uint_as_float((unsigned)b << 16); }

__global__ void __launch_bounds__(NWAVES * 64, 2) hybrid_fwd(Args args) {
    extern __shared__ __attribute__((aligned(16))) unsigned char lds[];
    Frame F;
    F.lds = (LAS unsigned char*)lds;
    F.MISC = (volatile LAS unsigned*)(F.lds + MISC_OFF);
    F.tid = threadIdx.x; F.lane = F.tid & 63; F.wave = __builtin_amdgcn_readfirstlane(F.tid >> 6);
    F.G = gridDim.x; { const int bx = blockIdx.x; F.vcu = (F.G % 8 == 0) ? (bx % 8) * (F.G / 8) + bx / 8 : bx; }
    unsigned char* ws = args.ws;
    F.ctl = (gu32*)(ws + WS_CTL);
    bf16* const Win_t = (bf16*)(ws + WS_WIN); bf16* const Wpc_t = (bf16*)(ws + WS_WPC); bf16* const Wpa_t = (bf16*)(ws + WS_WPA);
    bf16* const Wout_t = (bf16*)(ws + WS_WOUT); bf16* const Wup_t = (bf16*)(ws + WS_WUP); bf16* const Wdn_t = (bf16*)(ws + WS_WDN);
    bf16* const HB = (bf16*)(ws + WS_H); bf16* const CUB = (bf16*)(ws + WS_CU); bf16* const BGB = (bf16*)(ws + WS_BG);
    bf16* const QB = (bf16*)(ws + WS_Q); bf16* const KB = (bf16*)(ws + WS_K); bf16* const VB = (bf16*)(ws + WS_V);
    bf16* const SGC = (bf16*)(ws + WS_SGC); bf16* const SGA = (bf16*)(ws + WS_SGA); bf16* const BCB = (bf16*)(ws + WS_BC); bf16* const OB = (bf16*)(ws + WS_O);
    bf16* const T1 = (bf16*)(ws + WS_T1); bf16* const MG = (bf16*)(ws + WS_MG); float* const X1 = (float*)(ws + WS_X1); bf16* const GB = (bf16*)(ws + WS_G);
    float* const PT = (float*)(ws + WS_PT); float* const PO = (float*)(ws + WS_PO);
    for (int u = F.tid; u < (LDS_BYTES - LDSCTL_OFF) / 4; u += NWAVES * 64) ((LAS unsigned*)(F.lds + LDSCTL_OFF))[u] = 0u;
    __syncthreads();
    XcdBarrier bar = xcd_barrier_post((unsigned*)(F.ctl + CW_BAR), F.MISC + 8);
    const int gw = F.vcu * NWAVES + F.wave, NGW = F.G * NWAVES;
    const int gtid = blockIdx.x * (NWAVES * 64) + F.tid, NGT = F.G * NWAVES * 64;

    const int lo = args.ph_lo, hi = args.ph_hi;
#define IN(k) (lo <= (k) && (k) < hi)
#define SEAM(k) do { if (IN(k) && IN((k) + 1)) xcd_barrier(bar); } while (0)
    if (IN(0)) {
        LAS float* scr = (LAS float*)(F.lds + RING_OFF + F.wave * 16384);
        constexpr int I_IN = (DM / 64) * (DIN / 32), I_PC = (DCONV / 64) * (DM / 32), I_PA = (DATT / 64) * (DM / 32), I_OUT = (DM / 64) * (DM / 32), I_UP = (DM / 64) * (DFF / 32), I_DN = (DFF / 64) * (DM / 32);
        constexpr int NITEMS = I_IN + I_PC + I_PA + I_OUT + I_UP + I_DN;
        for (int it = gw; it < NITEMS; it += NGW) {
            int r = it;
            if (r < I_IN) { const int nblk = DIN / 32, kb = r / nblk, nb = r % nblk; transpose_item(args.win, DM, DIN, Win_t, scr, kb, nb, win_src_col(32 * nb), F.lane); continue; } r -= I_IN;
            if (r < I_PC) { const int nblk = DM / 32, kb = r / nblk, nb = r % nblk; transpose_item(args.wpc, DCONV, DM, Wpc_t, scr, kb, nb, 32 * nb, F.lane); continue; } r -= I_PC;
            if (r < I_PA) { const int nblk = DM / 32, kb = r / nblk, nb = r % nblk; transpose_item(args.wpa, DATT, DM, Wpa_t, scr, kb, nb, 32 * nb, F.lane); continue; } r -= I_PA;
            if (r < I_OUT) { const int nblk = DM / 32, kb = r / nblk, nb = r % nblk; transpose_item(args.wout, DM, DM, Wout_t, scr, kb, nb, 32 * nb, F.lane); continue; } r -= I_OUT;
            if (r < I_UP) { const int nblk = DFF / 32, kb = r / nblk, nb = r % nblk; transpose_item(args.wup, DM, DFF, Wup_t, scr, kb, nb, 32 * nb, F.lane); continue; } r -= I_UP;
            { const int nblk = DM / 32, kb = r / nblk, nb = r % nblk; transpose_item(args.wdn, DFF, DM, Wdn_t, scr, kb, nb, 32 * nb, F.lane); }
        }
        for (int m = gw; m < MT; m += NGW) rms_row_to_bf16(F.lane, m < MP ? args.xp + (size_t)m * DM : args.xs + (size_t)(m - MP) * DM, args.n1w, HB + (size_t)m * DM);
    }
    SEAM(0);

    if (IN(1)) {
        pg8::Gemm g{HB, Win_t, MT, DIN, DM}; pg8::StaticOrder S; S.init(MT, DIN, F.G, (int)blockIdx.x);
        pg8::EpiProj E{CUB, BGB, QB, KB, VB, SGC, SGA, args.out, C2};
        pg8::gemm_phase<pg8::EpiProj, pg8::StaticOrder, GEMM_ALIGN, GEMM_SP2>(F.lds + RING_OFF, g, S, E);
    }
    SEAM(1);

    if (IN(2)) {
        for (int it = gtid; it < MT * 64; it += NGT) {
            const int row = it >> 6, j = (it & 63) * 8;
            f32x4 c0a, c0b, c1a, c1b, c2a, c2b, ba, bb;
            pg8::unpack8(*(const pg8::u32x4*)(CUB + (size_t)row * 512 + j), c2a, c2b);
            pg8::unpack8(*(const pg8::u32x4*)(BGB + (size_t)row * 512 + j), ba, bb);
            int t; const float* st = nullptr;
            if (row < MP) { t = row & (SEQ - 1); } else { const int r = row - MP; t = r & 7; st = args.sc + (size_t)(r >> 3) * 2 * 512 + j; }
            const f32x4 z4 = {0.f, 0.f, 0.f, 0.f};
            if (t >= 1) pg8::unpack8(*(const pg8::u32x4*)(CUB + (size_t)(row - 1) * 512 + j), c1a, c1b);
            else if (st) { c1a = *(const f32x4*)(st + 512); c1b = *(const f32x4*)(st + 512 + 4); } else { c1a = z4; c1b = z4; }
            if (t >= 2) pg8::unpack8(*(const pg8::u32x4*)(CUB + (size_t)(row - 2) * 512 + j), c0a, c0b);
            else if (st) { const float* s2 = st + (t == 1 ? 512 : 0); c0a = *(const f32x4*)s2; c0b = *(const f32x4*)(s2 + 4); } else { c0a = z4; c0b = z4; }
            const f32x4 w0a = *(const f32x4*)(args.cw + j), w0b = *(const f32x4*)(args.cw + j + 4), w1a = *(const f32x4*)(args.cw + 512 + j), w1b = *(const f32x4*)(args.cw + 512 + j + 4),
                        w2a = *(const f32x4*)(args.cw + 1024 + j), w2b = *(const f32x4*)(args.cw + 1024 + j + 4);
            const f32x4 ra = ba * (w0a * c0a + w1a * c1a + w2a * c2a), rb = bb * (w0b * c0b + w1b * c1b + w2b * c2b);
            *(pg8::u32x4*)(BCB + (size_t)row * 512 + j) = pg8::pack8(ra, rb);
        }
        LAS unsigned char* tileK = F.lds + RING_OFF; LAS unsigned char* tileV = F.lds + RING_OFF + 8192;
        for (int unit = blockIdx.x; unit < 256; unit += F.G) {
            const int bh = unit >> 4, b = bh >> 3, h = bh & 7, T0 = (unit & 15) * 512, t = T0 + F.tid; const size_t row = (size_t)b * SEQ + t;
            float q[64], o[64];
#pragma unroll
            for (int c = 0; c < 8; ++c) { f32x4 a, bq; pg8::unpack8(*(const pg8::u32x4*)(QB + row * 512 + h * 64 + c * 8), a, bq);
                q[c * 8 + 0] = a[0]; q[c * 8 + 1] = a[1]; q[c * 8 + 2] = a[2]; q[c * 8 + 3] = a[3]; q[c * 8 + 4] = bq[0]; q[c * 8 + 5] = bq[1]; q[c * 8 + 6] = bq[2]; q[c * 8 + 7] = bq[3]; }
#pragma unroll
            for (int d = 0; d < 64; ++d) o[d] = 0.f;
            float Dp = 1.0f; const float biasl = args.ab[h] * LOG2E;
            const int twmax = T0 + F.wave * 64 + 63;
            for (int tile = (T0 + 512) / 64 - 1; tile >= 0; --tile) {
                const int s0 = tile * 64;
                __syncthreads();
                { const int r = F.tid >> 3, c = F.tid & 7; const size_t src = ((size_t)b * SEQ + s0 + r) * 512 + h * 64 + c * 8;
                  *(LAS pg8::u32x4*)(tileK + r * 128 + c * 16) = *(const pg8::u32x4*)(KB + src); *(LAS pg8::u32x4*)(tileV + r * 128 + c * 16) = *(const pg8::u32x4*)(VB + src); }
                __syncthreads();
                if (s0 < twmax) {
                    for (int s = 63; s >= 0; --s) {
                        float dot = 0.f;
#pragma unroll
                        for (int c = 0; c < 8; ++c) { f32x4 a, bk; pg8::unpack8(*(const LAS pg8::u32x4*)(tileK + s * 128 + c * 16), a, bk);
                            dot += q[c * 8 + 0] * a[0] + q[c * 8 + 1] * a[1] + q[c * 8 + 2] * a[2] + q[c * 8 + 3] * a[3] + q[c * 8 + 4] * bk[0] + q[c * 8 + 5] * bk[1] + q[c * 8 + 6] * bk[2] + q[c * 8 + 7] * bk[3]; }
                        float e = __builtin_amdgcn_exp2f(dot + biasl);
                        if (s0 + s >= t) e = 0.f;
                        Dp *= (1.0f + e);
                        const float w = e * __builtin_amdgcn_rcpf(Dp);
#pragma unroll
                        for (int c = 0; c < 8; ++c) { f32x4 a, bv; pg8::unpack8(*(const LAS pg8::u32x4*)(tileV + s * 128 + c * 16), a, bv);
                            o[c * 8 + 0] += w * a[0]; o[c * 8 + 1] += w * a[1]; o[c * 8 + 2] += w * a[2]; o[c * 8 + 3] += w * a[3]; o[c * 8 + 4] += w * bv[0]; o[c * 8 + 5] += w * bv[1]; o[c * 8 + 6] += w * bv[2]; o[c * 8 + 7] += w * bv[3]; }
                    }
                }
            }
#pragma unroll
            for (int c = 0; c < 8; ++c) *(pg8::u32x4*)(OB + row * 512 + h * 64 + c * 8) = pg8::pack8((f32x4){o[c * 8], o[c * 8 + 1], o[c * 8 + 2], o[c * 8 + 3]}, (f32x4){o[c * 8 + 4], o[c * 8 + 5], o[c * 8 + 6], o[c * 8 + 7]});
        }
        for (int item = gtid; item < DB * NPAGES * 64; item += NGT) {
            const int i = item & 7, h = (item >> 3) & 7, j = (item >> 6) & 63, b = item >> 12;
            const size_t qrow = (size_t)MP + b * 8 + i;
            float q[64], o[64];
#pragma unroll
            for (int c = 0; c < 8; ++c) { f32x4 a, bq; pg8::unpack8(*(const pg8::u32x4*)(QB + qrow * 512 + h * 64 + c * 8), a, bq);
                q[c * 8 + 0] = a[0]; q[c * 8 + 1] = a[1]; q[c * 8 + 2] = a[2]; q[c * 8 + 3] = a[3]; q[c * 8 + 4] = bq[0]; q[c * 8 + 5] = bq[1]; q[c * 8 + 6] = bq[2]; q[c * 8 + 7] = bq[3]; }
#pragma unroll
            for (int d = 0; d < 64; ++d) o[d] = 0.f;
            float Dp = 1.0f; const float biasl = args.ab[h] * LOG2E;
            const int page = args.pt[b * NPAGES + j];
            const float* kp = args.ck + ((size_t)page * PAGE) * 512 + h * 64; const float* vp = args.cv + ((size_t)page * PAGE) * 512 + h * 64;
            for (int s = PAGE - 1; s >= 0; --s) {
                float dot = 0.f;
#pragma unroll
                for (int c = 0; c < 16; ++c) { const f32x4 a = *(const f32x4*)(kp + (size_t)s * 512 + c * 4); dot += q[c * 4] * a[0] + q[c * 4 + 1] * a[1] + q[c * 4 + 2] * a[2] + q[c * 4 + 3] * a[3]; }
                const float e = __builtin_amdgcn_exp2f(dot + biasl);
                Dp *= (1.0f + e);
                const float w = e * __builtin_amdgcn_rcpf(Dp);
#pragma unroll
                for (int c = 0; c < 16; ++c) { const f32x4 a = *(const f32x4*)(vp + (size_t)s * 512 + c * 4); o[c * 4] += w * a[0]; o[c * 4 + 1] += w * a[1]; o[c * 4 + 2] += w * a[2]; o[c * 4 + 3] += w * a[3]; }
            }
            const size_t pidx = ((size_t)((b * 8 + h) * 8 + i)) * 64 + j;
            PT[pidx] = Dp;
#pragma unroll
            for (int c = 0; c < 16; ++c) *(f32x4*)(PO + pidx * 64 + c * 4) = (f32x4){o[c * 4], o[c * 4 + 1], o[c * 4 + 2], o[c * 4 + 3]};
        }
    }
    SEAM(2);

    if (IN(3)) {
        for (int item = gtid; item < MS * 8 * 64; item += NGT) {
            const int d = item & 63, i = (item >> 6) & 7, h = (item >> 9) & 7, b = item >> 12;
            const size_t qrow = (size_t)MP + b * 8 + i;
            float Dp = 1.0f, acc = 0.f; const float biasl = args.ab[h] * LOG2E;
            for (int jn = i - 1; jn >= 0; --jn) {
                const size_t krow = (size_t)MP + b * 8 + jn; float dot = 0.f;
                for (int dd = 0; dd < 64; ++dd) dot += bf2f(QB[qrow * 512 + h * 64 + dd]) * bf2f(KB[krow * 512 + h * 64 + dd]);
                const float e = __builtin_amdgcn_exp2f(dot + biasl);
                Dp *= (1.0f + e);
                acc += e * __builtin_amdgcn_rcpf(Dp) * bf2f(VB[krow * 512 + h * 64 + d]);
            }
            const size_t pbase = ((size_t)((b * 8 + h) * 8 + i)) * 64;
            for (int j = NPAGES - 1; j >= 0; --j) { acc += PO[(pbase + j) * 64 + d] * __builtin_amdgcn_rcpf(Dp); Dp *= PT[pbase + j]; }
            OB[qrow * 512 + h * 64 + d] = (bf16)f2bf(acc);
        }
        pg8::Gemm g{BCB, Wpc_t, MT, DM, DCONV}; pg8::StaticOrder S; S.init(MT, DM, F.G, (int)blockIdx.x);
        pg8::EpiBf<0> E{T1, DM, SGC, nullptr};
        pg8::gemm_phase<pg8::EpiBf<0>, pg8::StaticOrder, GEMM_ALIGN, GEMM_SP2>(F.lds + RING_OFF, g, S, E);
    }
    SEAM(3);

    if (IN(4)) {
        pg8::Gemm g{OB, Wpa_t, MT, DM, DATT}; pg8::StaticOrder S; S.init(MT, DM, F.G, (int)blockIdx.x);
        pg8::EpiBf<1> E{MG, DM, SGA, T1};
        pg8::gemm_phase<pg8::EpiBf<1>, pg8::StaticOrder, GEMM_ALIGN, GEMM_SP2>(F.lds + RING_OFF, g, S, E);
    }
    SEAM(4);

    if (IN(5)) {
        pg8::Gemm g{MG, Wout_t, MT, DM, DM}; pg8::StaticOrder S; S.init(MT, DM, F.G, (int)blockIdx.x);
        pg8::EpiResF32 E{args.xp, args.xs, X1};
        pg8::gemm_phase<pg8::EpiResF32, pg8::StaticOrder, GEMM_ALIGN, GEMM_SP2>(F.lds + RING_OFF, g, S, E);
    }
    SEAM(5);

    if (IN(6)) for (int m = gw; m < MT; m += NGW) rms_row_to_bf16(F.lane, X1 + (size_t)m * DM, args.n2w, HB + (size_t)m * DM);
    SEAM(6);

    if (IN(7)) {
        pg8::Gemm g{HB, Wup_t, MT, DFF, DM}; pg8::StaticOrder S; S.init(MT, DFF, F.G, (int)blockIdx.x);
        pg8::EpiBf<2> E{GB, DFF, nullptr, nullptr};
        pg8::gemm_phase<pg8::EpiBf<2>, pg8::StaticOrder, GEMM_ALIGN, GEMM_SP2>(F.lds + RING_OFF, g, S, E);
    }
    SEAM(7);

    if (IN(8)) {
        pg8::Gemm g{GB, Wdn_t, MT, DM, DFF}; pg8::StaticOrder S; S.init(MT, DM, F.G, (int)blockIdx.x);
        pg8::EpiResF32 E{X1, X1 + (size_t)MP * DM, args.out + OFF_Y};
        pg8::gemm_phase<pg8::EpiResF32, pg8::StaticOrder, GEMM_ALIGN, GEMM_SP2>(F.lds + RING_OFF, g, S, E);
    }
    SEAM(8);

    if (IN(9)) {
    const bool poison = __hip_atomic_load((gu32*)((unsigned*)(F.ctl + CW_BAR) + XB_TMO), RLX_AGENT) != 0u;
    for (int m = gw; m < MT; m += NGW) rms_row_to_f32(F.lane, args.out + OFF_Y + (size_t)m * DM, args.nfw, args.out + OFF_Y + (size_t)m * DM, poison);
    }
#undef IN
#undef SEAM
}

extern "C" void kernel_launch(void* const* d_in, const int* in_sizes, int n_in, void* d_out, int out_size, void* d_ws, size_t ws_size, hipStream_t stream) {
    static int grid = 0;
    if (grid == 0) {
        if (n_in != 17 || (size_t)out_size != OUT_ELEMS || ws_size < WS_END) { fprintf(stderr, "kernel_launch: unexpected problem shape (n_in %d out %d ws %zu)\n", n_in, out_size, ws_size); grid = -1; return; }
        int dev = 0, cus = 0, per_cu = 0;
        if (hipGetDevice(&dev) != hipSuccess || hipDeviceGetAttribute(&cus, hipDeviceAttributeMultiprocessorCount, dev) != hipSuccess) { grid = -1; return; }
        if (hipFuncSetAttribute((const void*)hybrid_fwd, hipFuncAttributeMaxDynamicSharedMemorySize, LDS_BYTES) != hipSuccess) { fprintf(stderr, "kernel_launch: hipFuncSetAttribute failed\n"); grid = -1; return; }
        if (hipOccupancyMaxActiveBlocksPerMultiprocessor(&per_cu, (const void*)hybrid_fwd, NWAVES * 64, LDS_BYTES) != hipSuccess || per_cu < 1) { fprintf(stderr, "kernel_launch: occupancy query says %d\n", per_cu); }
        (void)hipGetLastError();
        grid = cus;
    }
    if (grid < 0) return;
    if (hipMemsetAsync((char*)d_ws + WS_CTL, 0, CTL_ZERO_BYTES, stream) != hipSuccess) return;
    Args a{};
    a.xp = (const float*)d_in[0]; a.xs = (const float*)d_in[1]; a.ck = (const float*)d_in[2]; a.cv = (const float*)d_in[3]; a.sc = (const float*)d_in[4]; a.pt = (const int*)d_in[5];
    a.n1w = (const float*)d_in[6]; a.win = (const float*)d_in[7]; a.cw = (const float*)d_in[8]; a.wpc = (const float*)d_in[9]; a.wpa = (const float*)d_in[10]; a.ab = (const float*)d_in[11];
    a.wout = (const float*)d_in[12]; a.n2w = (const float*)d_in[13]; a.wup = (const float*)d_in[14]; a.wdn = (const float*)d_in[15]; a.nfw = (const float*)d_in[16];
    a.out = (float*)d_out; a.ws = (unsigned char*)d_ws;
    constexpr int NPH = 10;
#ifndef MK_PER_PHASE
#define MK_PER_PHASE 0
#endif
    if (MK_PER_PHASE) { for (int k = 0; k < NPH; ++k) { a.ph_lo = k; a.ph_hi = k + 1; hipLaunchKernelGGL(hybrid_fwd, dim3(grid), dim3(NWAVES * 64), LDS_BYTES, stream, a); } }
    else { a.ph_lo = 0; a.ph_hi = NPH; hipLaunchKernelGGL(hybrid_fwd, dim3(grid), dim3(NWAVES * 64), LDS_BYTES, stream, a); }
}
```

```cpp
#include <hip/hip_runtime.h>
#include <cstdio>
#include <cstdint>
namespace pg8 {
#define PG8_LAS __attribute__((address_space(3)))
typedef unsigned short bf16_t;
typedef short bf16x8 __attribute__((ext_vector_type(8)));
typedef float f32x4 __attribute__((ext_vector_type(4)));
typedef unsigned u32x4 __attribute__((ext_vector_type(4)));
constexpr int BM = 256, BK = 64, HALF = 128, HTB = HALF * BK * 2  , STAGE_BYTES = 8 * HTB, NXCD = 8, WGM = 8;

__host__ __device__ __forceinline__ int lds_byte(int r, int c) { const int st = (r >> 4) * 2 + (c >> 5), rr = r & 15, cc = c & 31, ob = rr * 64 + cc * 2; return st * 1024 + (ob ^ (((ob >> 9) & 1) << 5)); }
__host__ __device__ __forceinline__ void stage_rc(int b, int& R, int& C) { const int st = b / 1024, sb = b % 1024, swz = sb ^ (((sb >> 9) & 1) << 5); R = (st >> 1) * 16 + swz / 64; C = (st & 1) * 32 + (swz % 64) / 2; }
__host__ __device__ __forceinline__ int perm32(int rho) { const int n = rho >> 4, i = rho & 15; return 8 * (i >> 2) + 4 * n + (i & 3); }

struct Unit { int pm, pn; };
struct Gemm { const bf16_t* A; const bf16_t* Bt; int M, N, K; };

struct StaticOrder {
    int nM, nN, nwg, G, c;
    __host__ __device__ void init(int M, int N, int G_, int c_) { nM = M / BM; nN = N / BM; nwg = nM * nN; G = G_; c = c_; }
    __host__ __device__ bool next(int i, Unit& u) const {
        const long L = (long)i * G + c; if (L >= nwg) return false;
        int wgid = (int)L; { const int q = nwg / NXCD, r = nwg % NXCD, xcd = wgid % NXCD, off = wgid / NXCD; wgid = (xcd < r ? xcd * (q + 1) : r * (q + 1) + (xcd - r) * q) + off; }
        const int nig = WGM * nN, gid = wgid / nig, fm = gid * WGM, gsz = (nM - fm) < WGM ? (nM - fm) : WGM;
        u.pm = fm + ((wgid % nig) % gsz); u.pn = (wgid % nig) / gsz; return true;
    }
    __device__ __forceinline__ void a_ready(const Unit&) const {}
    __device__ __forceinline__ void done(const Unit&) const {}
};

typedef float f32x2c_t __attribute__((ext_vector_type(2))); typedef __bf16 bf16x2c_t __attribute__((ext_vector_type(2)));
__device__ __forceinline__ unsigned cvt_pk_bf16(float lo, float hi) { f32x2c_t v = {lo, hi}; bf16x2c_t b = __builtin_convertvector(v, bf16x2c_t); return __builtin_bit_cast(unsigned, b); }
typedef float f32x2 __attribute__((ext_vector_type(2)));
typedef unsigned u32x2 __attribute__((ext_vector_type(2)));
constexpr int MP = 16384;
constexpr size_t OFF_Y = 0, OFF_KP = 17039360, OFF_VP = 25427968, OFF_CP = 33816576, OFF_KS = 33818624, OFF_VS = 33949696, OFF_CS = 34080768;
__device__ __forceinline__ u32x4 pack8(f32x4 a, f32x4 b) { u32x4 w; w.x = cvt_pk_bf16(a[0], a[1]); w.y = cvt_pk_bf16(a[2], a[3]); w.z = cvt_pk_bf16(b[0], b[1]); w.w = cvt_pk_bf16(b[2], b[3]); return w; }
__device__ __forceinline__ void unpack8(u32x4 w, f32x4& a, f32x4& b) {
    a[0] = __uint_as_float(w.x << 16); a[1] = __uint_as_float(w.x & 0xffff0000u); a[2] = __uint_as_float(w.y << 16); a[3] = __uint_as_float(w.y & 0xffff0000u);
    b[0] = __uint_as_float(w.z << 16); b[1] = __uint_as_float(w.z & 0xffff0000u); b[2] = __uint_as_float(w.w << 16); b[3] = __uint_as_float(w.w & 0xffff0000u); }
__device__ __forceinline__ float sigmoidf_fast(float x) { return __builtin_amdgcn_rcpf(1.0f + __builtin_amdgcn_exp2f(-1.4426950408889634f * x)); }
__device__ __forceinline__ f32x4 sig4(f32x4 v) { f32x4 r; r[0] = sigmoidf_fast(v[0]); r[1] = sigmoidf_fast(v[1]); r[2] = sigmoidf_fast(v[2]); r[3] = sigmoidf_fast(v[3]); return r; }

struct EpiProj {
    static constexpr bool PERM = true, AFTER_DRAIN = false;
    bf16_t *CU, *BG, *Q, *KB, *VB, *SGC, *SGA; float* out; float qscale;
    __device__ __forceinline__ void operator()(const f32x4 (&acc)[2][2][4][2], const Unit& u, int wr, int wc, int fr, int fq) const {
        const int row0 = u.pm * BM + wr * 64 + fr, c8 = wc * 32 + 8 * fq, pn = u.pn;
        if (pn < 4) {
            const int j = pn * 128 + c8;
#pragma unroll
            for (int ai = 0; ai < 2; ++ai)
#pragma unroll
                for (int m = 0; m < 4; ++m) { const int row = row0 + ai * HALF + m * 16;
                    const f32x4 a0 = acc[ai][0][m][0] * acc[ai][1][m][0], a1 = acc[ai][0][m][1] * acc[ai][1][m][1];
                    *(u32x4*)(CU + (size_t)row * 512 + j) = pack8(a0, a1);
                    float* cs = nullptr;
                    if (row < MP) { const int t = row & 8191; if (t >= 8190) cs = out + OFF_CP + (size_t)(((row >> 13) * 2 + (t - 8190)) * 512 + j); }
                    else { const int r = row - MP, i = r & 7; if (i >= 6) cs = out + OFF_CS + (size_t)(((r >> 3) * 2 + (i - 6)) * 512 + j); }
                    if (cs) { *(f32x4*)cs = a0; *(f32x4*)(cs + 4) = a1; } }
        } else if (pn < 12) {
            const int kind = (pn - 4) >> 1;
            bf16_t* dst = BG + (size_t)kind * (size_t)(18u << 19); const float sc = kind == 1 ? qscale : 1.0f;
            const int colb = ((pn - 4) & 1) * 256 + c8;
#pragma unroll
            for (int ai = 0; ai < 2; ++ai)
#pragma unroll
                for (int m = 0; m < 4; ++m) { const int row = row0 + ai * HALF + m * 16;
#pragma unroll
                    for (int bj = 0; bj < 2; ++bj) { const int col = colb + bj * HALF; const f32x4 v0 = acc[ai][bj][m][0] * sc, v1 = acc[ai][bj][m][1] * sc;
                        *(u32x4*)(dst + (size_t)row * 512 + col) = pack8(v0, v1);
                        if (kind >= 2) { float* o = out + (kind == 2 ? (row < MP ? OFF_KP : OFF_KS) : (row < MP ? OFF_VP : OFF_VS)) + (size_t)(row < MP ? row : row - MP) * 512 + col;
                            *(f32x4*)o = v0; *(f32x4*)(o + 4) = v1; } } }
        } else {
            bf16_t* dst = pn < 16 ? SGC : SGA; const int colb = ((pn - 12) & 3) * 256 + c8;
#pragma unroll
            for (int ai = 0; ai < 2; ++ai)
#pragma unroll
                for (int m = 0; m < 4; ++m) { const int row = row0 + ai * HALF + m * 16;
#pragma unroll
                    for (int bj = 0; bj < 2; ++bj) { const int col = colb + bj * HALF;
                        *(u32x4*)(dst + (size_t)row * 1024 + col) = pack8(sig4(acc[ai][bj][m][0]), sig4(acc[ai][bj][m][1])); } }
        }
    }
};
template <int MODE> struct EpiBf {
    static constexpr bool PERM = true, AFTER_DRAIN = false;
    bf16_t* O; int ldc; const bf16_t* G1; const bf16_t* ADD;
    __device__ __forceinline__ void operator()(const f32x4 (&acc)[2][2][4][2], const Unit& u, int wr, int wc, int fr, int fq) const {
        const int row0 = u.pm * BM + wr * 64 + fr, col0 = u.pn * BM + wc * 32 + 8 * fq;
#pragma unroll
        for (int ai = 0; ai < 2; ++ai)
#pragma unroll
            for (int m = 0; m < 4; ++m) { const size_t ro = (size_t)(row0 + ai * HALF + m * 16) * ldc + col0;
#pragma unroll
                for (int bj = 0; bj < 2; ++bj) { f32x4 v0 = acc[ai][bj][m][0], v1 = acc[ai][bj][m][1];
                    if (MODE == 0 || MODE == 1) { f32x4 g0, g1; unpack8(*(const u32x4*)(G1 + ro + bj * HALF), g0, g1); v0 = v0 * g0; v1 = v1 * g1; }
                    if (MODE == 1) { f32x4 t0, t1; unpack8(*(const u32x4*)(ADD + ro + bj * HALF), t0, t1); v0 = v0 + t0; v1 = v1 + t1; }
                    if (MODE == 2) { v0 = __builtin_elementwise_max(v0, (f32x4){0.f, 0.f, 0.f, 0.f}); v1 = __builtin_elementwise_max(v1, (f32x4){0.f, 0.f, 0.f, 0.f}); v0 = v0 * v0; v1 = v1 * v1; }
                    *(u32x4*)(O + ro + bj * HALF) = pack8(v0, v1); } }
    }
};
struct EpiResF32 {
    static constexpr bool PERM = false, AFTER_DRAIN = false;
    const float* base0; const float* base1; float* out;
    __device__ __forceinline__ void operator()(const f32x4 (&acc)[2][2][4][2], const Unit& u, int wr, int wc, int fr, int fq) const {
        const int row0 = u.pm * BM + wr * 64 + fr, col0 = u.pn * BM + wc * 32 + 4 * fq;
#pragma unroll
        for (int ai = 0; ai < 2; ++ai)
#pragma unroll
            for (int m = 0; m < 4; ++m) { const int row = row0 + ai * HALF + m * 16; const float* bp = (row < MP ? base0 + (size_t)row * 1024 : base1 + (size_t)(row - MP) * 1024) + col0; float* op = out + (size_t)row * 1024 + col0;
#pragma unroll
                for (int bj = 0; bj < 2; ++bj)
#pragma unroll
                    for (int n = 0; n < 2; ++n) *(f32x4*)(op + bj * HALF + n * 16) = *(const f32x4*)(bp + bj * HALF + n * 16) + acc[ai][bj][m][n]; }
    }
};
template <class Epi, class Sched, bool ALIGN_EPI = false, bool SP2 = false>
__device__ __forceinline__ void gemm_phase(PG8_LAS unsigned char* lds, const Gemm g, const Sched& S, const Epi& E) {
    const int tid = threadIdx.x, wid = __builtin_amdgcn_readfirstlane(tid >> 6), lane = tid & 63, wr = wid >> 2, wc = wid & 3, fr = lane & 15, fq = lane >> 4;
    const int K = g.K, nt = K / BK;
    unsigned voffA[2], voffB[2];
#pragma unroll
    for (int i = 0; i < 2; ++i) { int R, C; stage_rc(tid * 16 + i * 8192, R, C); const int Rb = Epi::PERM ? ((R & ~31) + perm32(R & 31)) : R;
        voffA[i] = (unsigned)(R * K + C) * 2u; voffB[i] = (unsigned)(Rb * K + C) * 2u; }
    const size_t kstep = (size_t)(BK * 2);
    const size_t hstep = (size_t)HALF * K * 2;
    const size_t tstep = 2 * hstep;
    const unsigned ldsw = (unsigned)wid * 1024u;
    const int aoff = lds_byte(wr * 64 + fr, fq * 8), boff = lds_byte(wc * 32 + fr, fq * 8);
#define PG8_SA(b, h) (((b) * 2 + (h)) * HTB)
#define PG8_SB(b, h) ((4 + (b) * 2 + (h)) * HTB)
#define PG8_STAGE(bufoff, gbase, voff) do { _Pragma("unroll") for (int _i = 0; _i < 2; ++_i) \
        __builtin_amdgcn_global_load_lds((const unsigned*)((const char*)(gbase) + (voff)[_i]), (PG8_LAS unsigned*)(lds + (bufoff) + ldsw + _i * 8192), 16, 0, 0); } while (0)
#define PG8_LDA(dst, b, h) do { _Pragma("unroll") for (int m = 0; m < 4; ++m) _Pragma("unroll") for (int k = 0; k < 2; ++k) dst[m][k] = *(const PG8_LAS bf16x8*)(lds + PG8_SA(b, h) + aoff + m * 2048 + k * 1024); } while (0)
#define PG8_LDB(dst, b, h) do { _Pragma("unroll") for (int n = 0; n < 2; ++n) _Pragma("unroll") for (int k = 0; k < 2; ++k) dst[n][k] = *(const PG8_LAS bf16x8*)(lds + PG8_SB(b, h) + boff + n * 2048 + k * 1024); } while (0)
#define PG8_MMA(ai, bj, At, Bt) do { __builtin_amdgcn_s_setprio(1); _Pragma("unroll") for (int m = 0; m < 4; ++m) _Pragma("unroll") for (int n = 0; n < 2; ++n) _Pragma("unroll") for (int k = 0; k < 2; ++k) \
        acc[ai][bj][m][n] = __builtin_amdgcn_mfma_f32_16x16x32_bf16(Bt[n][k], At[m][k], acc[ai][bj][m][n], 0, 0, 0); __builtin_amdgcn_s_setprio(0); } while (0)
#define PG8_WAIT_V(n) asm volatile("s_waitcnt vmcnt(" #n ")" ::: "memory")
#define PG8_WAIT_L(n) asm volatile("s_waitcnt lgkmcnt(" #n ")" ::: "memory")
#define PG8_BAR __builtin_amdgcn_s_barrier()
#define PG8_SCHED __builtin_amdgcn_sched_barrier(0)
    Unit cur, nxt; int ui = 0;
    if (!S.next(0, cur)) return;
    f32x4 acc[2][2][4][2];
#pragma unroll
    for (int a = 0; a < 2; ++a)
#pragma unroll
        for (int b = 0; b < 2; ++b)
#pragma unroll
            for (int m = 0; m < 4; ++m)
#pragma unroll
                for (int n = 0; n < 2; ++n) acc[a][b][m][n] = (f32x4){0.f, 0.f, 0.f, 0.f};
    bf16x8 At[4][2], B0[2][2], B1[2][2];
    const char* cA = (const char*)g.A + (size_t)cur.pm * tstep; const char* cB = (const char*)g.Bt + (size_t)cur.pn * tstep;
    S.a_ready(cur);
    if constexpr (SP2) {
        PG8_STAGE(PG8_SB(0, 0), cB, voffB); PG8_STAGE(PG8_SB(0, 1), cB + hstep, voffB); PG8_STAGE(PG8_SA(0, 0), cA, voffA); PG8_STAGE(PG8_SA(0, 1), cA + hstep, voffA);
        if (wr == 1) PG8_BAR;
        PG8_WAIT_V(2); PG8_BAR;
        PG8_STAGE(PG8_SB(1, 0), cB + kstep, voffB); PG8_STAGE(PG8_SA(1, 0), cA + kstep, voffA); PG8_STAGE(PG8_SB(1, 1), cB + hstep + kstep, voffB);
        PG8_WAIT_V(6); PG8_BAR;
    } else {
        PG8_STAGE(PG8_SB(0, 0), cB, voffB); PG8_STAGE(PG8_SA(0, 0), cA, voffA); PG8_STAGE(PG8_SB(0, 1), cB + hstep, voffB); PG8_STAGE(PG8_SA(0, 1), cA + hstep, voffA);
        if (wr == 1) PG8_BAR;
        PG8_WAIT_V(4); PG8_BAR;
        PG8_STAGE(PG8_SB(1, 0), cB + kstep, voffB); PG8_STAGE(PG8_SA(1, 0), cA + kstep, voffA); PG8_STAGE(PG8_SB(1, 1), cB + hstep + kstep, voffB);
        PG8_WAIT_V(6); PG8_BAR;
    }
    for (;;) {
        const bool has_next = S.next(ui + 1, nxt);
        const char* nA = has_next ? (const char*)g.A + (size_t)nxt.pm * tstep : cA; const char* nB = has_next ? (const char*)g.Bt + (size_t)nxt.pn * tstep : cB;
        for (int t = 0; t < nt; t += 2) {
            const bool last = (t == nt - 2);
            const char* a1 = cA + (size_t)(t + 1) * kstep;
            const char* a2 = last ? nA : cA + (size_t)(t + 2) * kstep; const char* b2 = last ? nB : cB + (size_t)(t + 2) * kstep;
            const char* a3 = a2 + kstep; const char* b3 = b2 + kstep;
            if (last && has_next) S.a_ready(nxt);
            if constexpr (SP2) {
            PG8_LDB(B0, 0, 0); PG8_LDB(B1, 0, 1); PG8_SCHED; PG8_LDA(At, 0, 0); PG8_STAGE(PG8_SA(1, 1), a1 + hstep, voffA);
            PG8_WAIT_V(8); PG8_WAIT_L(0); PG8_BAR; PG8_MMA(0, 0, At, B0); PG8_MMA(0, 1, At, B1); PG8_BAR; PG8_SCHED;
            PG8_LDA(At, 0, 1); PG8_STAGE(PG8_SB(0, 0), b2, voffB); PG8_STAGE(PG8_SB(0, 1), b2 + hstep, voffB); PG8_STAGE(PG8_SA(0, 0), a2, voffA);
            PG8_WAIT_V(8); PG8_WAIT_L(0); PG8_BAR; PG8_MMA(1, 0, At, B0); PG8_MMA(1, 1, At, B1); PG8_BAR; PG8_SCHED;
            PG8_LDB(B0, 1, 0); PG8_LDB(B1, 1, 1); PG8_SCHED; PG8_LDA(At, 1, 0); PG8_STAGE(PG8_SA(0, 1), a2 + hstep, voffA);
            PG8_WAIT_V(8); PG8_WAIT_L(0); PG8_BAR; PG8_MMA(0, 0, At, B0); PG8_MMA(0, 1, At, B1); PG8_BAR; PG8_SCHED;
            PG8_LDA(At, 1, 1); PG8_STAGE(PG8_SB(1, 0), b3, voffB); PG8_STAGE(PG8_SB(1, 1), b3 + hstep, voffB); PG8_STAGE(PG8_SA(1, 0), a3, voffA);
            PG8_WAIT_V(8); PG8_WAIT_L(0); PG8_BAR; PG8_MMA(1, 0, At, B0); PG8_MMA(1, 1, At, B1); PG8_BAR; PG8_SCHED;
            } else {
            PG8_LDB(B0, 0, 0); PG8_SCHED; PG8_LDA(At, 0, 0); PG8_STAGE(PG8_SA(1, 1), a1 + hstep, voffA);
            PG8_WAIT_L(8); PG8_BAR; PG8_WAIT_L(0); PG8_MMA(0, 0, At, B0); PG8_BAR; PG8_SCHED;
            PG8_LDB(B1, 0, 1); PG8_STAGE(PG8_SB(0, 0), b2, voffB);
            PG8_BAR; PG8_WAIT_L(0); PG8_MMA(0, 1, At, B1); PG8_BAR;
            PG8_LDA(At, 0, 1); PG8_STAGE(PG8_SA(0, 0), a2, voffA);
            PG8_BAR; PG8_WAIT_L(0); PG8_MMA(1, 0, At, B0); PG8_BAR; PG8_SCHED;
            PG8_STAGE(PG8_SB(0, 1), b2 + hstep, voffB);
            PG8_WAIT_V(6); PG8_BAR; PG8_MMA(1, 1, At, B1); PG8_BAR;
            PG8_LDB(B0, 1, 0); PG8_SCHED; PG8_LDA(At, 1, 0); PG8_STAGE(PG8_SA(0, 1), a2 + hstep, voffA);
            PG8_WAIT_L(8); PG8_BAR; PG8_WAIT_L(0); PG8_MMA(0, 0, At, B0); PG8_BAR; PG8_SCHED;
            PG8_LDB(B1, 1, 1); PG8_STAGE(PG8_SB(1, 0), b3, voffB);
            PG8_BAR; PG8_WAIT_L(0); PG8_MMA(0, 1, At, B1); PG8_BAR;
            PG8_LDA(At, 1, 1); PG8_STAGE(PG8_SA(1, 0), a3, voffA);
            PG8_BAR; PG8_WAIT_L(0); PG8_MMA(1, 0, At, B0); PG8_BAR; PG8_SCHED;
            PG8_STAGE(PG8_SB(1, 1), b3 + hstep, voffB);
            PG8_WAIT_V(6); PG8_BAR; PG8_MMA(1, 1, At, B1); PG8_BAR;
            }
        }
        if constexpr (ALIGN_EPI) { if (wr == 0) PG8_BAR; }
        if constexpr (!Epi::AFTER_DRAIN) { E(acc, cur, wr, wc, fr, fq); S.done(cur); }
        if (!has_next) break;
#pragma unroll
        for (int a = 0; a < 2; ++a)
#pragma unroll
            for (int b = 0; b < 2; ++b)
#pragma unroll
                for (int m = 0; m < 4; ++m)
#pragma unroll
                    for (int n = 0; n < 2; ++n) acc[a][b][m][n] = (f32x4){0.f, 0.f, 0.f, 0.f};
        cur = nxt; cA = nA; cB = nB; ++ui;
        if constexpr (ALIGN_EPI) { if (wr == 1) PG8_BAR; }
    }
    PG8_WAIT_V(0);
    if constexpr (!ALIGN_EPI) { if (wr == 0) PG8_BAR; }
    PG8_BAR;
    if constexpr (Epi::AFTER_DRAIN) { E.fused(acc, cur, wr, wc, fr, fq, lds, wid, lane); S.done(cur); }
#undef PG8_SA
#undef PG8_SB
#undef PG8_STAGE
#undef PG8_LDA
#undef PG8_LDB
#undef PG8_MMA
#undef PG8_WAIT_V
#undef PG8_WAIT_L
#undef PG8_BAR
#undef PG8_SCHED
}
}
#define GAS __attribute__((address_space(1)))
#define LAS __attribute__((address_space(3)))
typedef unsigned short bf16;
typedef unsigned v4u __attribute__((ext_vector_type(4)));
typedef float f32x4 __attribute__((ext_vector_type(4)));
typedef short bf16x8 __attribute__((ext_vector_type(8)));
typedef GAS unsigned gu32;
typedef GAS unsigned long long gu64;
#define RLX_AGENT __ATOMIC_RELAXED, __HIP_MEMORY_SCOPE_AGENT
#define LDS_WAIT() asm volatile("s_waitcnt lgkmcnt(0)" ::: "memory")
#define VM_WAIT() asm volatile("s_waitcnt vmcnt(0)" ::: "memory")
__device__ __forceinline__ unsigned long long rt() { return __builtin_amdgcn_s_memrealtime(); }
__device__ __forceinline__ unsigned f2bf(float f) { unsigned u = __builtin_bit_cast(unsigned, f); return (u + 0x7fffu + ((u >> 16) & 1u)) >> 16; }
__device__ __forceinline__ unsigned pk2(float lo, float hi) { return f2bf(lo) | (f2bf(hi) << 16); }
#define XB_TMO      128
#define XB_XCNT(j)  (256  + 64 * (j))
#define XB_XSUB(j)  (1280 + 64 * (j))
#define XB_XGEN(j)  (2304 + 64 * (j))
#define XB_TOP      3328
#define XB_TOPGEN   3392
#define XCD_BAR_WORDS 3456
#define XB_SPIN_CAP (1u << 24)

__device__ __forceinline__ unsigned xb_ld(unsigned* p)              { return __hip_atomic_load(p, __ATOMIC_RELAXED, __HIP_MEMORY_SCOPE_AGENT); }
__device__ __forceinline__ unsigned xb_add(unsigned* p, unsigned v) { return __hip_atomic_fetch_add(p, v, __ATOMIC_RELAXED, __HIP_MEMORY_SCOPE_AGENT); }
__device__ __forceinline__ unsigned xb_xcc_id() { return (unsigned)__builtin_amdgcn_s_getreg((3 << 11) | 20) & 0xFu; }
#define XB_SPIN(cond, bar) do { unsigned _sp = 0; while (cond) { __builtin_amdgcn_s_sleep(1); \
    if ((++_sp & 255u) == 0u) { if (xb_ld(&(bar)[XB_TMO])) break; if (_sp > XB_SPIN_CAP) { atomicAdd(&(bar)[XB_TMO], 1u); break; } } } } while (0)

struct XcdBarrier {
    unsigned* bar; unsigned x;
    volatile LAS unsigned* st;
};

__device__ __forceinline__ XcdBarrier xcd_barrier_post(unsigned* bar, volatile LAS unsigned* st) {
    XcdBarrier b; b.bar = bar; b.x = xb_xcc_id(); b.st = st;
    if (threadIdx.x == 0) (void)xb_add(&bar[XB_XCNT(b.x)], 1u);
    return b;
}
__device__ __forceinline__ void xcd_barrier_complete(unsigned* bar, unsigned x, unsigned& nloc, unsigned& nx) {
    const unsigned G = gridDim.x * gridDim.y * gridDim.z;
    unsigned sum, cnt, mine, sp = 0u;
    for (;;) {
        sum = 0u; cnt = 0u; mine = 0u;
#pragma unroll
        for (unsigned j = 0; j < 16; ++j) { const unsigned c = xb_ld(&bar[XB_XCNT(j)]); sum += c; cnt += (c > 0u) ? 1u : 0u; mine = (j == x) ? c : mine; }
        if (sum == G) break;
        __builtin_amdgcn_s_sleep(1);
        if ((++sp & 255u) == 0u) { if (xb_ld(&bar[XB_TMO])) break; if (sp > XB_SPIN_CAP) { atomicAdd(&bar[XB_TMO], 1u); break; } }
    }
    nloc = mine > 0u ? mine : 1u; nx = cnt > 0u ? cnt : 1u;
}

__device__ __forceinline__ void xcd_barrier(const XcdBarrier& b) {
    asm volatile("s_waitcnt vmcnt(0)" ::: "memory");
    __syncthreads();
    if (threadIdx.x == 0) {
        unsigned* bar = b.bar;
        __builtin_amdgcn_s_waitcnt(0);
        unsigned nloc = b.st[0], nx = b.st[1];
        if (nloc == 0u) { xcd_barrier_complete(bar, b.x, nloc, nx); b.st[0] = nloc; b.st[1] = nx; }
        const unsigned old = xb_add(&bar[XB_XSUB(b.x)], 1u);
        const unsigned gen = old / nloc;
        if (old + 1u == (gen + 1u) * nloc) {
            __builtin_amdgcn_fence(__ATOMIC_RELEASE, "agent");
            asm volatile("s_waitcnt vmcnt(0)" ::: "memory");
            const unsigned og = xb_add(&bar[XB_TOP], 1u);
            const unsigned tg = og / nx;
            if (og + 1u == (tg + 1u) * nx) xb_add(&bar[XB_TOPGEN], 1u);
            else XB_SPIN(xb_ld(&bar[XB_TOPGEN]) == tg, bar);
            __builtin_amdgcn_fence(__ATOMIC_ACQUIRE, "agent");
            xb_add(&bar[XB_XGEN(b.x)], 1u);
            asm volatile("s_waitcnt vmcnt(0)" ::: "memory");
        } else {
            XB_SPIN(xb_ld(&bar[XB_XGEN(b.x)]) == gen, bar);
            __builtin_amdgcn_fence(__ATOMIC_ACQUIRE, "agent");
            asm volatile("s_waitcnt vmcnt(0)" ::: "memory");
        }
    }
    __syncthreads();
}
namespace sba {
using bf16x8 = __attribute__((ext_vector_type(8))) short;
using s16x4 = __attribute__((ext_vector_type(4))) short;
using f32x16 = __attribute__((ext_vector_type(16))) float;
using u32x4 = __attribute__((ext_vector_type(4))) unsigned;
typedef unsigned short bf16;
constexpr int SEQ = 8192, D = 64, PITCH = 512, NW = 8, QBLK = 32, QB = 256, KVBLK = 64;
constexpr int NSLOT = 3, SLOTB = 8192;
constexpr int LDS_K = 0, LDS_V = NSLOT * SLOTB, LDS_OST = 2 * NSLOT * SLOTB, LDS_BYTES = LDS_OST + NW * 4096;
__device__ __forceinline__ int crow(int r, int hi) { return (r & 3) + 8 * (r >> 2) + 4 * hi; }
__device__ __forceinline__ void glds16(const void* gsrc, unsigned lds_dst) { unsigned keep;
    asm volatile("s_mov_b32 %0, m0\n\ts_mov_b32 m0, %2\n\ts_nop 0\n\tglobal_load_lds_dwordx4 %1, off\n\ts_mov_b32 m0, %0" : "=&s"(keep) : "v"(gsrc), "s"(lds_dst) : "memory"); }
typedef float f32x2_t __attribute__((ext_vector_type(2))); typedef __bf16 bf16x2_t __attribute__((ext_vector_type(2)));
__device__ __forceinline__ unsigned cvtpk(float lo, float hi) { f32x2_t v = {lo, hi}; bf16x2_t b = __builtin_convertvector(v, bf16x2_t); return __builtin_bit_cast(unsigned, b); }
typedef __attribute__((address_space(3))) const char* lds_cptr;
typedef short v4i16_t __attribute__((ext_vector_type(4)));
__device__ __forceinline__ s16x4 vtr(lds_cptr p) { return __builtin_bit_cast(s16x4, __builtin_amdgcn_ds_read_tr16_b64_v4i16((__attribute__((address_space(3))) v4i16_t*)p)); }
#define SBA_WAIT_BAR(N) asm volatile("s_waitcnt vmcnt(" #N ") lgkmcnt(0)\n\ts_barrier" ::: "memory")

__device__ __forceinline__ void qkt(f32x16& p0, f32x16& p1, lds_cptr kb, const bf16x8* qr, const f32x16& cinit) {
#pragma unroll
    for (int d0 = 0; d0 < 4; ++d0) {
        const bf16x8 b0 = *(const __attribute__((address_space(3))) bf16x8*)(kb + d0 * 2048);
        const bf16x8 b1 = *(const __attribute__((address_space(3))) bf16x8*)(kb + d0 * 2048 + 512);
        if (d0 == 0) { p0 = __builtin_amdgcn_mfma_f32_32x32x16_bf16(b0, qr[0], cinit, 0, 0, 0); p1 = __builtin_amdgcn_mfma_f32_32x32x16_bf16(b1, qr[0], cinit, 0, 0, 0); }
        else { p0 = __builtin_amdgcn_mfma_f32_32x32x16_bf16(b0, qr[d0], p0, 0, 0, 0); p1 = __builtin_amdgcn_mfma_f32_32x32x16_bf16(b1, qr[d0], p1, 0, 0, 0); } }
}
__device__ __forceinline__ void pv(f32x16* o, lds_cptr vp, bf16x8 pa0, bf16x8 pa1, bf16x8 pa2, bf16x8 pa3) {
#pragma unroll
    for (int d0 = 0; d0 < 2; ++d0) { s16x4 lo[4], hi[4];
#pragma unroll
        for (int ks = 0; ks < 4; ++ks) { lo[ks] = vtr(vp + d0 * 4096 + ks * 1024); hi[ks] = vtr(vp + d0 * 4096 + ks * 1024 + 512); }
#define SBA_PK(k) (bf16x8){lo[k][0], lo[k][1], lo[k][2], lo[k][3], hi[k][0], hi[k][1], hi[k][2], hi[k][3]}
        o[d0] = __builtin_amdgcn_mfma_f32_32x32x16_bf16(pa0, SBA_PK(0), o[d0], 0, 0, 0);
        o[d0] = __builtin_amdgcn_mfma_f32_32x32x16_bf16(pa1, SBA_PK(1), o[d0], 0, 0, 0);
        o[d0] = __builtin_amdgcn_mfma_f32_32x32x16_bf16(pa2, SBA_PK(2), o[d0], 0, 0, 0);
        o[d0] = __builtin_amdgcn_mfma_f32_32x32x16_bf16(pa3, SBA_PK(3), o[d0], 0, 0, 0);
#undef SBA_PK
    }
}
__device__ __forceinline__ float sb_block(const f32x16& p, float Din, bool hiLane, u32x4& wA, u32x4& wB) {
    float e[16], a[16];
#pragma unroll
    for (int r = 0; r < 16; ++r) { e[r] = __builtin_amdgcn_exp2f(p[r]); a[r] = 1.0f + e[r]; }
    float own[4], PP[4], f[4];
#pragma unroll
    for (int j = 0; j < 4; ++j) { own[j] = (a[4 * j] * a[4 * j + 1]) * (a[4 * j + 2] * a[4 * j + 3]);
        const auto rr = __builtin_amdgcn_permlane32_swap(__float_as_uint(own[j]), __float_as_uint(own[j]), false, false);
        const float vlo = __uint_as_float(rr[0]), vhi = __uint_as_float(rr[1]);
        PP[j] = vlo * vhi; f[j] = hiLane ? 1.0f : vhi; }
    float base[4]; base[3] = Din; base[2] = base[3] * PP[3]; base[1] = base[2] * PP[2]; base[0] = base[1] * PP[1];
    const float Dout = base[0] * PP[0];
    float w[16];
#pragma unroll
    for (int j = 0; j < 4; ++j) { const float C = base[j] * f[j]; const float R0 = __builtin_amdgcn_rcpf(C * own[j]);
        w[4 * j] = e[4 * j] * R0; float t = R0 * a[4 * j]; w[4 * j + 1] = e[4 * j + 1] * t; t *= a[4 * j + 1]; w[4 * j + 2] = e[4 * j + 2] * t; t *= a[4 * j + 2]; w[4 * j + 3] = e[4 * j + 3] * t; }
    wA = (u32x4){cvtpk(w[0], w[1]), cvtpk(w[2], w[3]), cvtpk(w[4], w[5]), cvtpk(w[6], w[7])};
    wB = (u32x4){cvtpk(w[8], w[9]), cvtpk(w[10], w[11]), cvtpk(w[12], w[13]), cvtpk(w[14], w[15])};
    return Dout;
}
__device__ __forceinline__ void unit(int b, int h, int qb, const bf16* Q, const bf16* __restrict__ K, const bf16* __restrict__ V, bf16* O, float biasl, char* shm) {
    const int tid = threadIdx.x, lane = tid & 63, r32 = lane & 31, hi = lane >> 5; const int wid = __builtin_amdgcn_readfirstlane(tid >> 6);
    const long rowbase = (long)b * SEQ; const int q0 = qb * QB, NT = (q0 + QB) / KVBLK;
    const bf16* Qw = Q + (rowbase + q0 + wid * QBLK) * PITCH + h * D;
    const bf16* Kh = K + rowbase * PITCH + h * D; const bf16* Vh = V + rowbase * PITCH + h * D;
    const unsigned lds0 = (unsigned)(uintptr_t)shm;
    const bf16* ksrc = Kh + (long)lane * PITCH + wid * 8;
    const bf16* vsrc = Vh + (long)(16 * (wid & 3) + (lane >> 2)) * PITCH + (wid >> 2) * 32 + (lane & 3) * 8;
    const unsigned kdst = lds0 + LDS_K + wid * 1024, vdst = lds0 + LDS_V + wid * 1024;
#define SBA_DMA(t, slot) do { glds16(ksrc + (long)(t) * KVBLK * PITCH, (unsigned)__builtin_amdgcn_readfirstlane(kdst + (slot))); glds16(vsrc + (long)(t) * KVBLK * PITCH, (unsigned)__builtin_amdgcn_readfirstlane(vdst + (slot))); } while (0)
    const lds_cptr shm3 = (lds_cptr)shm; const lds_cptr kp0 = shm3 + LDS_K + hi * 1024 + r32 * 16;
    const lds_cptr vp0 = shm3 + LDS_V + ((lane >> 4) & 1) * 32 + (lane & 3) * 8 + (4 * hi + ((lane & 15) >> 2)) * 64;
    bf16x8 qr[4];
#pragma unroll
    for (int d0 = 0; d0 < 4; ++d0) qr[d0] = *reinterpret_cast<const bf16x8*>(&Qw[(long)r32 * PITCH + d0 * 16 + hi * 8]);
    SBA_DMA(NT - 1, 0); SBA_DMA(NT - 2, SLOTB);
    f32x16 o[2]; o[0] = f32x16{}; o[1] = f32x16{};
    f32x16 cinit;
#pragma unroll
    for (int r = 0; r < 16; ++r) cinit[r] = biasl;
    float Dc = 1.0f;
    const int qrel = wid * QBLK + r32;
    int slot = 0;
    for (int i = 0; i < NT; ++i) {
        const int t = NT - 1 - i;
        if (i + 1 < NT) SBA_WAIT_BAR(2); else SBA_WAIT_BAR(0);
        if (i + 2 < NT) { const int s2 = slot >= SLOTB ? slot - SLOTB : slot + 2 * SLOTB; SBA_DMA(t - 2, s2); }
        const int jb = t - (NT - 4);
        const bool skip = jb >= 0 && 64 * jb >= 32 * wid + 32;
        if (!skip) {
            f32x16 p0, p1;
            qkt(p0, p1, kp0 + slot, qr, cinit);
            if (jb >= 0 && 64 * jb + 63 >= 32 * wid) {
                const int kb = 64 * jb + 4 * hi;
#pragma unroll
                for (int r = 0; r < 16; ++r) { const int kv = kb + (r & 3) + 8 * (r >> 2); if (kv >= qrel) p0[r] = -INFINITY; if (kv + 32 >= qrel) p1[r] = -INFINITY; }
            }
            u32x4 w0, w1, w2, w3;
            const float Dm = sb_block(p1, Dc, hi != 0, w2, w3);
            Dc = sb_block(p0, Dm, hi != 0, w0, w1);
            pv(o, vp0 + slot, __builtin_bit_cast(bf16x8, w0), __builtin_bit_cast(bf16x8, w1), __builtin_bit_cast(bf16x8, w2), __builtin_bit_cast(bf16x8, w3));
        }
        slot = slot == (NSLOT - 1) * SLOTB ? 0 : slot + SLOTB;
    }
    bf16* Ow = O + (rowbase + q0 + wid * QBLK) * PITCH + h * D;
    { bf16* stg = (bf16*)(shm + LDS_OST) + wid * 2048;
#pragma unroll
      for (int r = 0; r < 16; ++r) { const int orow = crow(r, hi);
#pragma unroll
          for (int d0 = 0; d0 < 2; ++d0) stg[orow * 64 + d0 * 32 + r32] = (bf16)(cvtpk(o[d0][r], 0.f) & 0xffffu); }
      asm volatile("s_waitcnt lgkmcnt(0)" ::: "memory");
#pragma unroll
      for (int i = 0; i < 4; ++i) { const int row = i * 8 + (lane >> 3), ch = lane & 7; const u32x4 v = *(const u32x4*)(stg + row * 64 + ch * 8); *(u32x4*)(Ow + (long)row * PITCH + ch * 8) = v; } }
    asm volatile("s_waitcnt lgkmcnt(0)\n\ts_barrier" ::: "memory");
#undef SBA_DMA
}
#undef SBA_WAIT_BAR
}
constexpr int NWAVES = 8;
#ifndef GEMM_ALIGN
#define GEMM_ALIGN true
#endif
#ifndef GEMM_SP2
#define GEMM_SP2 true
#endif
constexpr int DM = 1024, SEQ = 8192, NB = 2, MP = NB * SEQ, DB = 32, DL = 8, MS = DB * DL, MT = MP + MS;
constexpr int DCONV = 512, NH = 8, HD = 64, DATT = 512, DFF = 4096, DIN = 5120, PAGE = 128, NPAGES = 64;
constexpr float RMS_EPS = 1e-6f, LOG2E = 1.4426950408889634f, C2 = 0.125f * LOG2E;
using pg8::OFF_Y; using pg8::OFF_KP; using pg8::OFF_VP; using pg8::OFF_CP; using pg8::OFF_KS; using pg8::OFF_VS; using pg8::OFF_CS;
constexpr size_t OUT_ELEMS = 34113536;

constexpr size_t MiB = 1u << 20;
constexpr size_t WS_CTL = 0, CTL_ZERO_BYTES = 1 * MiB;
constexpr size_t WS_WIN = 2 * MiB, WS_WPC = 12 * MiB, WS_WPA = 13 * MiB, WS_WOUT = 14 * MiB, WS_WUP = 16 * MiB, WS_WDN = 24 * MiB;
constexpr size_t WS_H = 32 * MiB;
constexpr size_t WS_CU = 66 * MiB;
constexpr size_t WS_BG = 84 * MiB;
constexpr size_t WS_Q = 102 * MiB, WS_K = 120 * MiB, WS_V = 138 * MiB;
constexpr size_t WS_SGC = 156 * MiB, WS_SGA = 190 * MiB;
constexpr size_t WS_BC = 224 * MiB;
constexpr size_t WS_O = 242 * MiB;
constexpr size_t WS_T1 = 260 * MiB;
constexpr size_t WS_MG = 294 * MiB;
constexpr size_t WS_X1 = 328 * MiB;
constexpr size_t WS_G = 394 * MiB;
constexpr size_t WS_PT = 526 * MiB;
constexpr size_t WS_PO = 527 * MiB;
constexpr size_t WS_END = 560 * MiB;
constexpr int CW_BAR = 4096;
static_assert(WS_Q - WS_BG == 18 * MiB && WS_K - WS_Q == 18 * MiB && WS_V - WS_K == 18 * MiB, "EpiProj addresses BG|Q|K|V by stride");

constexpr int RING_OFF = 0, RING_BYTES = 131072;
constexpr int LDSCTL_OFF = RING_BYTES, MISC_OFF = LDSCTL_OFF + 320;
constexpr int LDS_BYTES = 147456;

struct Args {
    const float *xp, *xs, *ck, *cv, *sc; const int* pt; const float *n1w, *win, *cw, *wpc, *wpa, *ab, *wout, *n2w, *wup, *wdn, *nfw;
    float* out; unsigned char* ws; int ph_lo, ph_hi;
};
struct Frame {
    LAS unsigned char* lds; volatile LAS unsigned* MISC; gu32* ctl;
    int tid, lane, wave, vcu, G;
};

__device__ __forceinline__ float wave_sum(float v) {
#pragma unroll
    for (int o = 1; o < 64; o <<= 1) v += __shfl_xor(v, o);
    return v;
}
__device__ __forceinline__ int win_src_col(int vc) {
    const int u = vc >> 8, r = vc & 255;
    if (u < 4) return (r < 128) ? 512 + 128 * u + r : 1024 + 128 * u + (r - 128);
    if (u < 6) return 256 * (u - 4) + r;
    if (u < 12) return 1536 + 256 * (u - 6) + r;
    return 3072 + 256 * (u - 12) + r;
}
__device__ __forceinline__ void transpose_item(const float* W, int K, int N, bf16* WT, LAS float* scr, int kb, int nb, int src_n0, int lane) {
    const int k0 = 64 * kb, n0 = 32 * nb;
#pragma unroll 8
    for (int i = 0; i < 32; ++i) { const int kk = 2 * i + (lane >> 5); scr[kk * 33 + (lane & 31)] = W[(size_t)(k0 + kk) * N + src_n0 + (lane & 31)]; }
    LDS_WAIT(); asm volatile("" ::: "memory");
    const int c = lane & 7;
#pragma unroll
    for (int j = 0; j < 4; ++j) { const int n = (lane >> 3) + 8 * j; const LAS float* s = scr + (8 * c) * 33 + n;
        v4u o; o.x = pk2(s[0 * 33], s[1 * 33]); o.y = pk2(s[2 * 33], s[3 * 33]); o.z = pk2(s[4 * 33], s[5 * 33]); o.w = pk2(s[6 * 33], s[7 * 33]);
        *(GAS v4u*)(WT + (size_t)(n0 + n) * K + k0 + 8 * c) = o; }
    LDS_WAIT(); asm volatile("" ::: "memory");
}
__device__ __forceinline__ void rms_row_to_bf16(int lane, const float* xrow, const float* w, bf16* orow) {
    const GAS f32x4* xr = (const GAS f32x4*)xrow + lane; const GAS f32x4* wr = (const GAS f32x4*)w + lane;
    f32x4 v[4]; float s = 0.f;
#pragma unroll
    for (int j = 0; j < 4; ++j) { v[j] = xr[64 * j]; s += (v[j].x * v[j].x + v[j].y * v[j].y) + (v[j].z * v[j].z + v[j].w * v[j].w); }
    const float rstd = 1.0f / sqrtf(wave_sum(s) * (1.f / DM) + RMS_EPS);
    GAS unsigned long long* o8 = (GAS unsigned long long*)orow + lane;
#pragma unroll
    for (int j = 0; j < 4; ++j) { const f32x4 g = wr[64 * j]; o8[64 * j] = (unsigned long long)pk2(v[j].x * rstd * g.x, v[j].y * rstd * g.y) | ((unsigned long long)pk2(v[j].z * rstd * g.z, v[j].w * rstd * g.w) << 32); }
}
__device__ __forceinline__ void rms_row_to_f32(int lane, const float* xrow, const float* w, float* orow, bool poison) {
    const GAS f32x4* xr = (const GAS f32x4*)xrow + lane; const GAS f32x4* wr = (const GAS f32x4*)w + lane;
    f32x4 v[4]; float s = 0.f;
#pragma unroll
    for (int j = 0; j < 4; ++j) { v[j] = xr[64 * j]; s += (v[j].x * v[j].x + v[j].y * v[j].y) + (v[j].z * v[j].z + v[j].w * v[j].w); }
    float rstd = 1.0f / sqrtf(wave_sum(s) * (1.f / DM) + RMS_EPS); if (poison) rstd = __builtin_nanf("");
    GAS f32x4* o = (GAS f32x4*)orow + lane;
#pragma unroll
    for (int j = 0; j < 4; ++j) { const f32x4 g = wr[64 * j]; o[64 * j] = v[j] * rstd * g; }
}
__device__ __forceinline__ float bf2f(unsigned short b) { return __uint_as_float((unsigned)b << 16); }

__global__ void __launch_bounds__(NWAVES * 64, 2) hybrid_fwd(Args args) {
    extern __shared__ __attribute__((aligned(16))) unsigned char lds[];
    Frame F;
    F.lds = (LAS unsigned char*)lds;
    F.MISC = (volatile LAS unsigned*)(F.lds + MISC_OFF);
    F.tid = threadIdx.x; F.lane = F.tid & 63; F.wave = __builtin_amdgcn_readfirstlane(F.tid >> 6);
    F.G = gridDim.x; { const int bx = blockIdx.x; F.vcu = (F.G % 8 == 0) ? (bx % 8) * (F.G / 8) + bx / 8 : bx; }
    unsigned char* ws = args.ws;
    F.ctl = (gu32*)(ws + WS_CTL);
    bf16* const Win_t = (bf16*)(ws + WS_WIN); bf16* const Wpc_t = (bf16*)(ws + WS_WPC); bf16* const Wpa_t = (bf16*)(ws + WS_WPA);
    bf16* const Wout_t = (bf16*)(ws + WS_WOUT); bf16* const Wup_t = (bf16*)(ws + WS_WUP); bf16* const Wdn_t = (bf16*)(ws + WS_WDN);
    bf16* const HB = (bf16*)(ws + WS_H); bf16* const CUB = (bf16*)(ws + WS_CU); bf16* const BGB = (bf16*)(ws + WS_BG);
    bf16* const QB = (bf16*)(ws + WS_Q); bf16* const KB = (bf16*)(ws + WS_K); bf16* const VB = (bf16*)(ws + WS_V);
    bf16* const SGC = (bf16*)(ws + WS_SGC); bf16* const SGA = (bf16*)(ws + WS_SGA); bf16* const BCB = (bf16*)(ws + WS_BC); bf16* const OB = (bf16*)(ws + WS_O);
    bf16* const T1 = (bf16*)(ws + WS_T1); bf16* const MG = (bf16*)(ws + WS_MG); float* const X1 = (float*)(ws + WS_X1); bf16* const GB = (bf16*)(ws + WS_G);
    float* const PT = (float*)(ws + WS_PT); float* const PO = (float*)(ws + WS_PO);
    for (int u = F.tid; u < (LDS_BYTES - LDSCTL_OFF) / 4; u += NWAVES * 64) ((LAS unsigned*)(F.lds + LDSCTL_OFF))[u] = 0u;
    __syncthreads();
    XcdBarrier bar = xcd_barrier_post((unsigned*)(F.ctl + CW_BAR), F.MISC + 8);
    const int gw = F.vcu * NWAVES + F.wave, NGW = F.G * NWAVES;
    const int gtid = blockIdx.x * (NWAVES * 64) + F.tid, NGT = F.G * NWAVES * 64;

    const int lo = args.ph_lo, hi = args.ph_hi;
#define IN(k) (lo <= (k) && (k) < hi)
#define SEAM(k) do { if (IN(k) && IN((k) + 1)) xcd_barrier(bar); } while (0)
    if (IN(0)) {
        LAS float* scr = (LAS float*)(F.lds + RING_OFF + F.wave * 16384);
        constexpr int I_IN = (DM / 64) * (DIN / 32), I_PC = (DCONV / 64) * (DM / 32), I_PA = (DATT / 64) * (DM / 32), I_OUT = (DM / 64) * (DM / 32), I_UP = (DM / 64) * (DFF / 32), I_DN = (DFF / 64) * (DM / 32);
        constexpr int NITEMS = I_IN + I_PC + I_PA + I_OUT + I_UP + I_DN;
        for (int it = gw; it < NITEMS; it += NGW) {
            int r = it;
            if (r < I_IN) { const int nblk = DIN / 32, kb = r / nblk, nb = r % nblk; transpose_item(args.win, DM, DIN, Win_t, scr, kb, nb, win_src_col(32 * nb), F.lane); continue; } r -= I_IN;
            if (r < I_PC) { const int nblk = DM / 32, kb = r / nblk, nb = r % nblk; transpose_item(args.wpc, DCONV, DM, Wpc_t, scr, kb, nb, 32 * nb, F.lane); continue; } r -= I_PC;
            if (r < I_PA) { const int nblk = DM / 32, kb = r / nblk, nb = r % nblk; transpose_item(args.wpa, DATT, DM, Wpa_t, scr, kb, nb, 32 * nb, F.lane); continue; } r -= I_PA;
            if (r < I_OUT) { const int nblk = DM / 32, kb = r / nblk, nb = r % nblk; transpose_item(args.wout, DM, DM, Wout_t, scr, kb, nb, 32 * nb, F.lane); continue; } r -= I_OUT;
            if (r < I_UP) { const int nblk = DFF / 32, kb = r / nblk, nb = r % nblk; transpose_item(args.wup, DM, DFF, Wup_t, scr, kb, nb, 32 * nb, F.lane); continue; } r -= I_UP;
            { const int nblk = DM / 32, kb = r / nblk, nb = r % nblk; transpose_item(args.wdn, DFF, DM, Wdn_t, scr, kb, nb, 32 * nb, F.lane); }
        }
        for (int m = gw; m < MT; m += NGW) rms_row_to_bf16(F.lane, m < MP ? args.xp + (size_t)m * DM : args.xs + (size_t)(m - MP) * DM, args.n1w, HB + (size_t)m * DM);
    }
    SEAM(0);

    if (IN(1)) {
        pg8::Gemm g{HB, Win_t, MT, DIN, DM}; pg8::StaticOrder S; S.init(MT, DIN, F.G, (int)blockIdx.x);
        pg8::EpiProj E{CUB, BGB, QB, KB, VB, SGC, SGA, args.out, C2};
        pg8::gemm_phase<pg8::EpiProj, pg8::StaticOrder, GEMM_ALIGN, GEMM_SP2>(F.lds + RING_OFF, g, S, E);
    }
    SEAM(1);

    if (IN(2)) {
        for (int it = gtid; it < MT * 64; it += NGT) {
            const int row = it >> 6, j = (it & 63) * 8;
            f32x4 c0a, c0b, c1a, c1b, c2a, c2b, ba, bb;
            pg8::unpack8(*(const pg8::u32x4*)(CUB + (size_t)row * 512 + j), c2a, c2b);
            pg8::unpack8(*(const pg8::u32x4*)(BGB + (size_t)row * 512 + j), ba, bb);
            int t; const float* st = nullptr;
            if (row < MP) { t = row & (SEQ - 1); } else { const int r = row - MP; t = r & 7; st = args.sc + (size_t)(r >> 3) * 2 * 512 + j; }
            const f32x4 z4 = {0.f, 0.f, 0.f, 0.f};
            if (t >= 1) pg8::unpack8(*(const pg8::u32x4*)(CUB + (size_t)(row - 1) * 512 + j), c1a, c1b);
            else if (st) { c1a = *(const f32x4*)(st + 512); c1b = *(const f32x4*)(st + 512 + 4); } else { c1a = z4; c1b = z4; }
            if (t >= 2) pg8::unpack8(*(const pg8::u32x4*)(CUB + (size_t)(row - 2) * 512 + j), c0a, c0b);
            else if (st) { const float* s2 = st + (t == 1 ? 512 : 0); c0a = *(const f32x4*)s2; c0b = *(const f32x4*)(s2 + 4); } else { c0a = z4; c0b = z4; }
            const f32x4 w0a = *(const f32x4*)(args.cw + j), w0b = *(const f32x4*)(args.cw + j + 4), w1a = *(const f32x4*)(args.cw + 512 + j), w1b = *(const f32x4*)(args.cw + 512 + j + 4),
                        w2a = *(const f32x4*)(args.cw + 1024 + j), w2b = *(const f32x4*)(args.cw + 1024 + j + 4);
            const f32x4 ra = ba * (w0a * c0a + w1a * c1a + w2a * c2a), rb = bb * (w0b * c0b + w1b * c1b + w2b * c2b);
            *(pg8::u32x4*)(BCB + (size_t)row * 512 + j) = pg8::pack8(ra, rb);
        }
        for (int v = F.vcu; v < 256; v += F.G) {
            const int bh = v >> 4, sq = v & 15; const float biasl = args.ab[bh & 7] * LOG2E;
            sba::unit(bh >> 3, bh & 7, 31 - sq, QB, KB, VB, OB, biasl, (char*)lds + RING_OFF);
            sba::unit(bh >> 3, bh & 7, sq, QB, KB, VB, OB, biasl, (char*)lds + RING_OFF);
        }
        for (int item = gtid; item < DB * NPAGES * 64; item += NGT) {
            const int i = item & 7, h = (item >> 3) & 7, j = (item >> 6) & 63, b = item >> 12;
            const size_t qrow = (size_t)MP + b * 8 + i;
            float q[64], o[64];
#pragma unroll
            for (int c = 0; c < 8; ++c) { f32x4 a, bq; pg8::unpack8(*(const pg8::u32x4*)(QB + qrow * 512 + h * 64 + c * 8), a, bq);
                q[c * 8 + 0] = a[0]; q[c * 8 + 1] = a[1]; q[c * 8 + 2] = a[2]; q[c * 8 + 3] = a[3]; q[c * 8 + 4] = bq[0]; q[c * 8 + 5] = bq[1]; q[c * 8 + 6] = bq[2]; q[c * 8 + 7] = bq[3]; }
#pragma unroll
            for (int d = 0; d < 64; ++d) o[d] = 0.f;
            float Dp = 1.0f; const float biasl = args.ab[h] * LOG2E;
            const int page = args.pt[b * NPAGES + j];
            const float* kp = args.ck + ((size_t)page * PAGE) * 512 + h * 64; const float* vp = args.cv + ((size_t)page * PAGE) * 512 + h * 64;
            for (int s = PAGE - 1; s >= 0; --s) {
                float dot = 0.f;
#pragma unroll
                for (int c = 0; c < 16; ++c) { const f32x4 a = *(const f32x4*)(kp + (size_t)s * 512 + c * 4); dot += q[c * 4] * a[0] + q[c * 4 + 1] * a[1] + q[c * 4 + 2] * a[2] + q[c * 4 + 3] * a[3]; }
                const float e = __builtin_amdgcn_exp2f(dot + biasl);
                Dp *= (1.0f + e);
                const float w = e * __builtin_amdgcn_rcpf(Dp);
#pragma unroll
                for (int c = 0; c < 16; ++c) { const f32x4 a = *(const f32x4*)(vp + (size_t)s * 512 + c * 4); o[c * 4] += w * a[0]; o[c * 4 + 1] += w * a[1]; o[c * 4 + 2] += w * a[2]; o[c * 4 + 3] += w * a[3]; }
            }
            const size_t pidx = ((size_t)((b * 8 + h) * 8 + i)) * 64 + j;
            PT[pidx] = Dp;
#pragma unroll
            for (int c = 0; c < 16; ++c) *(f32x4*)(PO + pidx * 64 + c * 4) = (f32x4){o[c * 4], o[c * 4 + 1], o[c * 4 + 2], o[c * 4 + 3]};
        }
    }
    SEAM(2);

    if (IN(3)) {
        for (int item = gtid; item < MS * 8 * 64; item += NGT) {
            const int d = item & 63, i = (item >> 6) & 7, h = (item >> 9) & 7, b = item >> 12;
            const size_t qrow = (size_t)MP + b * 8 + i;
            float Dp = 1.0f, acc = 0.f; const float biasl = args.ab[h] * LOG2E;
            for (int jn = i - 1; jn >= 0; --jn) {
                const size_t krow = (size_t)MP + b * 8 + jn; float dot = 0.f;
                for (int dd = 0; dd < 64; ++dd) dot += bf2f(QB[qrow * 512 + h * 64 + dd]) * bf2f(KB[krow * 512 + h * 64 + dd]);
                const float e = __builtin_amdgcn_exp2f(dot + biasl);
                Dp *= (1.0f + e);
                acc += e * __builtin_amdgcn_rcpf(Dp) * bf2f(VB[krow * 512 + h * 64 + d]);
            }
            const size_t pbase = ((size_t)((b * 8 + h) * 8 + i)) * 64;
            for (int j = NPAGES - 1; j >= 0; --j) { acc += PO[(pbase + j) * 64 + d] * __builtin_amdgcn_rcpf(Dp); Dp *= PT[pbase + j]; }
            OB[qrow * 512 + h * 64 + d] = (bf16)f2bf(acc);
        }
        pg8::Gemm g{BCB, Wpc_t, MT, DM, DCONV}; pg8::StaticOrder S; S.init(MT, DM, F.G, (int)blockIdx.x);
        pg8::EpiBf<0> E{T1, DM, SGC, nullptr};
        pg8::gemm_phase<pg8::EpiBf<0>, pg8::StaticOrder, GEMM_ALIGN, GEMM_SP2>(F.lds + RING_OFF, g, S, E);
    }
    SEAM(3);

    if (IN(4)) {
        pg8::Gemm g{OB, Wpa_t, MT, DM, DATT}; pg8::StaticOrder S; S.init(MT, DM, F.G, (int)blockIdx.x);
        pg8::EpiBf<1> E{MG, DM, SGA, T1};
        pg8::gemm_phase<pg8::EpiBf<1>, pg8::StaticOrder, GEMM_ALIGN, GEMM_SP2>(F.lds + RING_OFF, g, S, E);
    }
    SEAM(4);

    if (IN(5)) {
        pg8::Gemm g{MG, Wout_t, MT, DM, DM}; pg8::StaticOrder S; S.init(MT, DM, F.G, (int)blockIdx.x);
        pg8::EpiResF32 E{args.xp, args.xs, X1};
        pg8::gemm_phase<pg8::EpiResF32, pg8::StaticOrder, GEMM_ALIGN, GEMM_SP2>(F.lds + RING_OFF, g, S, E);
    }
    SEAM(5);

    if (IN(6)) for (int m = gw; m < MT; m += NGW) rms_row_to_bf16(F.lane, X1 + (size_t)m * DM, args.n2w, HB + (size_t)m * DM);
    SEAM(6);

    if (IN(7)) {
        pg8::Gemm g{HB, Wup_t, MT, DFF, DM}; pg8::StaticOrder S; S.init(MT, DFF, F.G, (int)blockIdx.x);
        pg8::EpiBf<2> E{GB, DFF, nullptr, nullptr};
        pg8::gemm_phase<pg8::EpiBf<2>, pg8::StaticOrder, GEMM_ALIGN, GEMM_SP2>(F.lds + RING_OFF, g, S, E);
    }
    SEAM(7);

    if (IN(8)) {
        pg8::Gemm g{GB, Wdn_t, MT, DM, DFF}; pg8::StaticOrder S; S.init(MT, DM, F.G, (int)blockIdx.x);
        pg8::EpiResF32 E{X1, X1 + (size_t)MP * DM, args.out + OFF_Y};
        pg8::gemm_phase<pg8::EpiResF32, pg8::StaticOrder, GEMM_ALIGN, GEMM_SP2>(F.lds + RING_OFF, g, S, E);
    }
    SEAM(8);

    if (IN(9)) {
    const bool poison = __hip_atomic_load((gu32*)((unsigned*)(F.ctl + CW_BAR) + XB_TMO), RLX_AGENT) != 0u;
    for (int m = gw; m < MT; m += NGW) rms_row_to_f32(F.lane, args.out + OFF_Y + (size_t)m * DM, args.nfw, args.out + OFF_Y + (size_t)m * DM, poison);
    }
#undef IN
#undef SEAM
}

extern "C" void kernel_launch(void* const* d_in, const int* in_sizes, int n_in, void* d_out, int out_size, void* d_ws, size_t ws_size, hipStream_t stream) {
    static int grid = 0;
    if (grid == 0) {
        if (n_in != 17 || (size_t)out_size != OUT_ELEMS || ws_size < WS_END) { fprintf(stderr, "kernel_launch: unexpected problem shape (n_in %d out %d ws %zu)\n", n_in, out_size, ws_size); grid = -1; return; }
        int dev = 0, cus = 0, per_cu = 0;
        if (hipGetDevice(&dev) != hipSuccess || hipDeviceGetAttribute(&cus, hipDeviceAttributeMultiprocessorCount, dev) != hipSuccess) { grid = -1; return; }
        if (hipFuncSetAttribute((const void*)hybrid_fwd, hipFuncAttributeMaxDynamicSharedMemorySize, LDS_BYTES) != hipSuccess) { fprintf(stderr, "kernel_launch: hipFuncSetAttribute failed\n"); grid = -1; return; }
        if (hipOccupancyMaxActiveBlocksPerMultiprocessor(&per_cu, (const void*)hybrid_fwd, NWAVES * 64, LDS_BYTES) != hipSuccess || per_cu < 1) { fprintf(stderr, "kernel_launch: occupancy query says %d\n", per_cu); }
        (void)hipGetLastError();
        grid = cus;
    }
    if (grid < 0) return;
    if (hipMemsetAsync((char*)d_ws + WS_CTL, 0, CTL_ZERO_BYTES, stream) != hipSuccess) return;
    Args a{};
    a.xp = (const float*)d_in[0]; a.xs = (const float*)d_in[1]; a.ck = (const float*)d_in[2]; a.cv = (const float*)d_in[3]; a.sc = (const float*)d_in[4]; a.pt = (const int*)d_in[5];
    a.n1w = (const float*)d_in[6]; a.win = (const float*)d_in[7]; a.cw = (const float*)d_in[8]; a.wpc = (const float*)d_in[9]; a.wpa = (const float*)d_in[10]; a.ab = (const float*)d_in[11];
    a.wout = (const float*)d_in[12]; a.n2w = (const float*)d_in[13]; a.wup = (const float*)d_in[14]; a.wdn = (const float*)d_in[15]; a.nfw = (const float*)d_in[16];
    a.out = (float*)d_out; a.ws = (unsigned char*)d_ws;
    constexpr int NPH = 10;
#ifndef MK_PER_PHASE
#define MK_PER_PHASE 0
#endif
    if (MK_PER_PHASE) { for (int k = 0; k < NPH; ++k) { a.ph_lo = k; a.ph_hi = k + 1; hipLaunchKernelGGL(hybrid_fwd, dim3(grid), dim3(NWAVES * 64), LDS_BYTES, stream, a); } }
    else { a.ph_lo = 0; a.ph_hi = NPH; hipLaunchKernelGGL(hybrid_fwd, dim3(grid), dim3(NWAVES * 64), LDS_BYTES, stream, a); }
}
```

```cpp
#include <hip/hip_runtime.h>
#include <cstdio>
#include <cstdint>
namespace pg8 {
#define PG8_LAS __attribute__((address_space(3)))
typedef unsigned short bf16_t;
typedef short bf16x8 __attribute__((ext_vector_type(8)));
typedef float f32x4 __attribute__((ext_vector_type(4)));
typedef unsigned u32x4 __attribute__((ext_vector_type(4)));
constexpr int BM = 256, BK = 64, HALF = 128, HTB = HALF * BK * 2  , STAGE_BYTES = 8 * HTB, NXCD = 8, WGM = 8;

__host__ __device__ __forceinline__ int lds_byte(int r, int c) { const int st = (r >> 4) * 2 + (c >> 5), rr = r & 15, cc = c & 31, ob = rr * 64 + cc * 2; return st * 1024 + (ob ^ (((ob >> 9) & 1) << 5)); }
__host__ __device__ __forceinline__ void stage_rc(int b, int& R, int& C) { const int st = b / 1024, sb = b % 1024, swz = sb ^ (((sb >> 9) & 1) << 5); R = (st >> 1) * 16 + swz / 64; C = (st & 1) * 32 + (swz % 64) / 2; }
__host__ __device__ __forceinline__ int perm32(int rho) { const int n = rho >> 4, i = rho & 15; return 8 * (i >> 2) + 4 * n + (i & 3); }

struct Unit { int pm, pn; };
struct Gemm { const bf16_t* A; const bf16_t* Bt; int M, N, K; };

struct StaticOrder {
    int nM, nN, nwg, G, c;
    __host__ __device__ void init(int M, int N, int G_, int c_) { nM = M / BM; nN = N / BM; nwg = nM * nN; G = G_; c = c_; }
    __host__ __device__ bool next(int i, Unit& u) const {
        const long L = (long)i * G + c; if (L >= nwg) return false;
        int wgid = (int)L; { const int q = nwg / NXCD, r = nwg % NXCD, xcd = wgid % NXCD, off = wgid / NXCD; wgid = (xcd < r ? xcd * (q + 1) : r * (q + 1) + (xcd - r) * q) + off; }
        const int nig = WGM * nN, gid = wgid / nig, fm = gid * WGM, gsz = (nM - fm) < WGM ? (nM - fm) : WGM;
        u.pm = fm + ((wgid % nig) % gsz); u.pn = (wgid % nig) / gsz; return true;
    }
    __device__ __forceinline__ void a_ready(const Unit&) const {}
    __device__ __forceinline__ void done(const Unit&) const {}
};

typedef float f32x2c_t __attribute__((ext_vector_type(2))); typedef __bf16 bf16x2c_t __attribute__((ext_vector_type(2)));
__device__ __forceinline__ unsigned cvt_pk_bf16(float lo, float hi) { f32x2c_t v = {lo, hi}; bf16x2c_t b = __builtin_convertvector(v, bf16x2c_t); return __builtin_bit_cast(unsigned, b); }
typedef float f32x2 __attribute__((ext_vector_type(2)));
typedef unsigned u32x2 __attribute__((ext_vector_type(2)));
constexpr int MP = 16384;
constexpr size_t OFF_Y = 0, OFF_KP = 17039360, OFF_VP = 25427968, OFF_CP = 33816576, OFF_KS = 33818624, OFF_VS = 33949696, OFF_CS = 34080768;
__device__ __forceinline__ u32x4 pack8(f32x4 a, f32x4 b) { u32x4 w; w.x = cvt_pk_bf16(a[0], a[1]); w.y = cvt_pk_bf16(a[2], a[3]); w.z = cvt_pk_bf16(b[0], b[1]); w.w = cvt_pk_bf16(b[2], b[3]); return w; }
__device__ __forceinline__ void unpack8(u32x4 w, f32x4& a, f32x4& b) {
    a[0] = __uint_as_float(w.x << 16); a[1] = __uint_as_float(w.x & 0xffff0000u); a[2] = __uint_as_float(w.y << 16); a[3] = __uint_as_float(w.y & 0xffff0000u);
    b[0] = __uint_as_float(w.z << 16); b[1] = __uint_as_float(w.z & 0xffff0000u); b[2] = __uint_as_float(w.w << 16); b[3] = __uint_as_float(w.w & 0xffff0000u); }
__device__ __forceinline__ float sigmoidf_fast(float x) { return __builtin_amdgcn_rcpf(1.0f + __builtin_amdgcn_exp2f(-1.4426950408889634f * x)); }
__device__ __forceinline__ f32x4 sig4(f32x4 v) { f32x4 r; r[0] = sigmoidf_fast(v[0]); r[1] = sigmoidf_fast(v[1]); r[2] = sigmoidf_fast(v[2]); r[3] = sigmoidf_fast(v[3]); return r; }

struct EpiProj {
    static constexpr bool PERM = true, AFTER_DRAIN = false;
    bf16_t *CU, *BG, *Q, *KB, *VB, *SGC, *SGA; float* out; float qscale;
    __device__ __forceinline__ void operator()(const f32x4 (&acc)[2][2][4][2], const Unit& u, int wr, int wc, int fr, int fq) const {
        const int row0 = u.pm * BM + wr * 64 + fr, c8 = wc * 32 + 8 * fq, pn = u.pn;
        if (pn < 4) {
            const int j = pn * 128 + c8;
#pragma unroll
            for (int ai = 0; ai < 2; ++ai)
#pragma unroll
                for (int m = 0; m < 4; ++m) { const int row = row0 + ai * HALF + m * 16;
                    const f32x4 a0 = acc[ai][0][m][0] * acc[ai][1][m][0], a1 = acc[ai][0][m][1] * acc[ai][1][m][1];
                    *(u32x4*)(CU + (size_t)row * 512 + j) = pack8(a0, a1);
                    float* cs = nullptr;
                    if (row < MP) { const int t = row & 8191; if (t >= 8190) cs = out + OFF_CP + (size_t)(((row >> 13) * 2 + (t - 8190)) * 512 + j); }
                    else { const int r = row - MP, i = r & 7; if (i >= 6) cs = out + OFF_CS + (size_t)(((r >> 3) * 2 + (i - 6)) * 512 + j); }
                    if (cs) { *(f32x4*)cs = a0; *(f32x4*)(cs + 4) = a1; } }
        } else if (pn < 12) {
            const int kind = (pn - 4) >> 1;
            bf16_t* dst = BG + (size_t)kind * (size_t)(18u << 19); const float sc = kind == 1 ? qscale : 1.0f;
            const int colb = ((pn - 4) & 1) * 256 + c8;
#pragma unroll
            for (int ai = 0; ai < 2; ++ai)
#pragma unroll
                for (int m = 0; m < 4; ++m) { const int row = row0 + ai * HALF + m * 16;
#pragma unroll
                    for (int bj = 0; bj < 2; ++bj) { const int col = colb + bj * HALF; const f32x4 v0 = acc[ai][bj][m][0] * sc, v1 = acc[ai][bj][m][1] * sc;
                        *(u32x4*)(dst + (size_t)row * 512 + col) = pack8(v0, v1);
                        if (kind >= 2) { float* o = out + (kind == 2 ? (row < MP ? OFF_KP : OFF_KS) : (row < MP ? OFF_VP : OFF_VS)) + (size_t)(row < MP ? row : row - MP) * 512 + col;
                            *(f32x4*)o = v0; *(f32x4*)(o + 4) = v1; } } }
        } else {
            bf16_t* dst = pn < 16 ? SGC : SGA; const int colb = ((pn - 12) & 3) * 256 + c8;
#pragma unroll
            for (int ai = 0; ai < 2; ++ai)
#pragma unroll
                for (int m = 0; m < 4; ++m) { const int row = row0 + ai * HALF + m * 16;
#pragma unroll
                    for (int bj = 0; bj < 2; ++bj) { const int col = colb + bj * HALF;
                        *(u32x4*)(dst + (size_t)row * 1024 + col) = pack8(sig4(acc[ai][bj][m][0]), sig4(acc[ai][bj][m][1])); } }
        }
    }
};
template <int MODE> struct EpiBf {
    static constexpr bool PERM = true, AFTER_DRAIN = false;
    bf16_t* O; int ldc; const bf16_t* G1; const bf16_t* ADD;
    __device__ __forceinline__ void operator()(const f32x4 (&acc)[2][2][4][2], const Unit& u, int wr, int wc, int fr, int fq) const {
        const int row0 = u.pm * BM + wr * 64 + fr, col0 = u.pn * BM + wc * 32 + 8 * fq;
#pragma unroll
        for (int ai = 0; ai < 2; ++ai)
#pragma unroll
            for (int m = 0; m < 4; ++m) { const size_t ro = (size_t)(row0 + ai * HALF + m * 16) * ldc + col0;
#pragma unroll
                for (int bj = 0; bj < 2; ++bj) { f32x4 v0 = acc[ai][bj][m][0], v1 = acc[ai][bj][m][1];
                    if (MODE == 0 || MODE == 1) { f32x4 g0, g1; unpack8(*(const u32x4*)(G1 + ro + bj * HALF), g0, g1); v0 = v0 * g0; v1 = v1 * g1; }
                    if (MODE == 1) { f32x4 t0, t1; unpack8(*(const u32x4*)(ADD + ro + bj * HALF), t0, t1); v0 = v0 + t0; v1 = v1 + t1; }
                    if (MODE == 2) { v0 = __builtin_elementwise_max(v0, (f32x4){0.f, 0.f, 0.f, 0.f}); v1 = __builtin_elementwise_max(v1, (f32x4){0.f, 0.f, 0.f, 0.f}); v0 = v0 * v0; v1 = v1 * v1; }
                    *(u32x4*)(O + ro + bj * HALF) = pack8(v0, v1); } }
    }
};
struct EpiResF32 {
    static constexpr bool PERM = false, AFTER_DRAIN = false;
    const float* base0; const float* base1; float* out;
    __device__ __forceinline__ void operator()(const f32x4 (&acc)[2][2][4][2], const Unit& u, int wr, int wc, int fr, int fq) const {
        const int row0 = u.pm * BM + wr * 64 + fr, col0 = u.pn * BM + wc * 32 + 4 * fq;
#pragma unroll
        for (int ai = 0; ai < 2; ++ai)
#pragma unroll
            for (int m = 0; m < 4; ++m) { const int row = row0 + ai * HALF + m * 16; const float* bp = (row < MP ? base0 + (size_t)row * 1024 : base1 + (size_t)(row - MP) * 1024) + col0; float* op = out + (size_t)row * 1024 + col0;
#pragma unroll
                for (int bj = 0; bj < 2; ++bj)
#pragma unroll
                    for (int n = 0; n < 2; ++n) *(f32x4*)(op + bj * HALF + n * 16) = *(const f32x4*)(bp + bj * HALF + n * 16) + acc[ai][bj][m][n]; }
    }
};
template <class Epi, class Sched, bool ALIGN_EPI = false, bool SP2 = false>
__device__ __forceinline__ void gemm_phase(PG8_LAS unsigned char* lds, const Gemm g, const Sched& S, const Epi& E) {
    const int tid = threadIdx.x, wid = __builtin_amdgcn_readfirstlane(tid >> 6), lane = tid & 63, wr = wid >> 2, wc = wid & 3, fr = lane & 15, fq = lane >> 4;
    const int K = g.K, nt = K / BK;
    unsigned voffA[2], voffB[2];
#pragma unroll
    for (int i = 0; i < 2; ++i) { int R, C; stage_rc(tid * 16 + i * 8192, R, C); const int Rb = Epi::PERM ? ((R & ~31) + perm32(R & 31)) : R;
        voffA[i] = (unsigned)(R * K + C) * 2u; voffB[i] = (unsigned)(Rb * K + C) * 2u; }
    const size_t kstep = (size_t)(BK * 2);
    const size_t hstep = (size_t)HALF * K * 2;
    const size_t tstep = 2 * hstep;
    const unsigned ldsw = (unsigned)wid * 1024u;
    const int aoff = lds_byte(wr * 64 + fr, fq * 8), boff = lds_byte(wc * 32 + fr, fq * 8);
#define PG8_SA(b, h) (((b) * 2 + (h)) * HTB)
#define PG8_SB(b, h) ((4 + (b) * 2 + (h)) * HTB)
#define PG8_STAGE(bufoff, gbase, voff) do { _Pragma("unroll") for (int _i = 0; _i < 2; ++_i) \
        __builtin_amdgcn_global_load_lds((const unsigned*)((const char*)(gbase) + (voff)[_i]), (PG8_LAS unsigned*)(lds + (bufoff) + ldsw + _i * 8192), 16, 0, 0); } while (0)
#define PG8_LDA(dst, b, h) do { _Pragma("unroll") for (int m = 0; m < 4; ++m) _Pragma("unroll") for (int k = 0; k < 2; ++k) dst[m][k] = *(const PG8_LAS bf16x8*)(lds + PG8_SA(b, h) + aoff + m * 2048 + k * 1024); } while (0)
#define PG8_LDB(dst, b, h) do { _Pragma("unroll") for (int n = 0; n < 2; ++n) _Pragma("unroll") for (int k = 0; k < 2; ++k) dst[n][k] = *(const PG8_LAS bf16x8*)(lds + PG8_SB(b, h) + boff + n * 2048 + k * 1024); } while (0)
#define PG8_MMA(ai, bj, At, Bt) do { __builtin_amdgcn_s_setprio(1); _Pragma("unroll") for (int m = 0; m < 4; ++m) _Pragma("unroll") for (int n = 0; n < 2; ++n) _Pragma("unroll") for (int k = 0; k < 2; ++k) \
        acc[ai][bj][m][n] = __builtin_amdgcn_mfma_f32_16x16x32_bf16(Bt[n][k], At[m][k], acc[ai][bj][m][n], 0, 0, 0); __builtin_amdgcn_s_setprio(0); } while (0)
#define PG8_WAIT_V(n) asm volatile("s_waitcnt vmcnt(" #n ")" ::: "memory")
#define PG8_WAIT_L(n) asm volatile("s_waitcnt lgkmcnt(" #n ")" ::: "memory")
#define PG8_BAR __builtin_amdgcn_s_barrier()
#define PG8_SCHED __builtin_amdgcn_sched_barrier(0)
    Unit cur, nxt; int ui = 0;
    if (!S.next(0, cur)) return;
    f32x4 acc[2][2][4][2];
#pragma unroll
    for (int a = 0; a < 2; ++a)
#pragma unroll
        for (int b = 0; b < 2; ++b)
#pragma unroll
            for (int m = 0; m < 4; ++m)
#pragma unroll
                for (int n = 0; n < 2; ++n) acc[a][b][m][n] = (f32x4){0.f, 0.f, 0.f, 0.f};
    bf16x8 At[4][2], B0[2][2], B1[2][2];
    const char* cA = (const char*)g.A + (size_t)cur.pm * tstep; const char* cB = (const char*)g.Bt + (size_t)cur.pn * tstep;
    S.a_ready(cur);
    if constexpr (SP2) {
        PG8_STAGE(PG8_SB(0, 0), cB, voffB); PG8_STAGE(PG8_SB(0, 1), cB + hstep, voffB); PG8_STAGE(PG8_SA(0, 0), cA, voffA); PG8_STAGE(PG8_SA(0, 1), cA + hstep, voffA);
        if (wr == 1) PG8_BAR;
        PG8_WAIT_V(2); PG8_BAR;
        PG8_STAGE(PG8_SB(1, 0), cB + kstep, voffB); PG8_STAGE(PG8_SA(1, 0), cA + kstep, voffA); PG8_STAGE(PG8_SB(1, 1), cB + hstep + kstep, voffB);
        PG8_WAIT_V(6); PG8_BAR;
    } else {
        PG8_STAGE(PG8_SB(0, 0), cB, voffB); PG8_STAGE(PG8_SA(0, 0), cA, voffA); PG8_STAGE(PG8_SB(0, 1), cB + hstep, voffB); PG8_STAGE(PG8_SA(0, 1), cA + hstep, voffA);
        if (wr == 1) PG8_BAR;
        PG8_WAIT_V(4); PG8_BAR;
        PG8_STAGE(PG8_SB(1, 0), cB + kstep, voffB); PG8_STAGE(PG8_SA(1, 0), cA + kstep, voffA); PG8_STAGE(PG8_SB(1, 1), cB + hstep + kstep, voffB);
        PG8_WAIT_V(6); PG8_BAR;
    }
    for (;;) {
        const bool has_next = S.next(ui + 1, nxt);
        const char* nA = has_next ? (const char*)g.A + (size_t)nxt.pm * tstep : cA; const char* nB = has_next ? (const char*)g.Bt + (size_t)nxt.pn * tstep : cB;
        for (int t = 0; t < nt; t += 2) {
            const bool last = (t == nt - 2);
            const char* a1 = cA + (size_t)(t + 1) * kstep;
            const char* a2 = last ? nA : cA + (size_t)(t + 2) * kstep; const char* b2 = last ? nB : cB + (size_t)(t + 2) * kstep;
            const char* a3 = a2 + kstep; const char* b3 = b2 + kstep;
            if (last && has_next) S.a_ready(nxt);
            if constexpr (SP2) {
            PG8_LDB(B0, 0, 0); PG8_LDB(B1, 0, 1); PG8_SCHED; PG8_LDA(At, 0, 0); PG8_STAGE(PG8_SA(1, 1), a1 + hstep, voffA);
            PG8_WAIT_V(8); PG8_WAIT_L(0); PG8_BAR; PG8_MMA(0, 0, At, B0); PG8_MMA(0, 1, At, B1); PG8_BAR; PG8_SCHED;
            PG8_LDA(At, 0, 1); PG8_STAGE(PG8_SB(0, 0), b2, voffB); PG8_STAGE(PG8_SB(0, 1), b2 + hstep, voffB); PG8_STAGE(PG8_SA(0, 0), a2, voffA);
            PG8_WAIT_V(8); PG8_WAIT_L(0); PG8_BAR; PG8_MMA(1, 0, At, B0); PG8_MMA(1, 1, At, B1); PG8_BAR; PG8_SCHED;
            PG8_LDB(B0, 1, 0); PG8_LDB(B1, 1, 1); PG8_SCHED; PG8_LDA(At, 1, 0); PG8_STAGE(PG8_SA(0, 1), a2 + hstep, voffA);
            PG8_WAIT_V(8); PG8_WAIT_L(0); PG8_BAR; PG8_MMA(0, 0, At, B0); PG8_MMA(0, 1, At, B1); PG8_BAR; PG8_SCHED;
            PG8_LDA(At, 1, 1); PG8_STAGE(PG8_SB(1, 0), b3, voffB); PG8_STAGE(PG8_SB(1, 1), b3 + hstep, voffB); PG8_STAGE(PG8_SA(1, 0), a3, voffA);
            PG8_WAIT_V(8); PG8_WAIT_L(0); PG8_BAR; PG8_MMA(1, 0, At, B0); PG8_MMA(1, 1, At, B1); PG8_BAR; PG8_SCHED;
            } else {
            PG8_LDB(B0, 0, 0); PG8_SCHED; PG8_LDA(At, 0, 0); PG8_STAGE(PG8_SA(1, 1), a1 + hstep, voffA);
            PG8_WAIT_L(8); PG8_BAR; PG8_WAIT_L(0); PG8_MMA(0, 0, At, B0); PG8_BAR; PG8_SCHED;
            PG8_LDB(B1, 0, 1); PG8_STAGE(PG8_SB(0, 0), b2, voffB);
            PG8_BAR; PG8_WAIT_L(0); PG8_MMA(0, 1, At, B1); PG8_BAR;
            PG8_LDA(At, 0, 1); PG8_STAGE(PG8_SA(0, 0), a2, voffA);
            PG8_BAR; PG8_WAIT_L(0); PG8_MMA(1, 0, At, B0); PG8_BAR; PG8_SCHED;
            PG8_STAGE(PG8_SB(0, 1), b2 + hstep, voffB);
            PG8_WAIT_V(6); PG8_BAR; PG8_MMA(1, 1, At, B1); PG8_BAR;
            PG8_LDB(B0, 1, 0); PG8_SCHED; PG8_LDA(At, 1, 0); PG8_STAGE(PG8_SA(0, 1), a2 + hstep, voffA);
            PG8_WAIT_L(8); PG8_BAR; PG8_WAIT_L(0); PG8_MMA(0, 0, At, B0); PG8_BAR; PG8_SCHED;
            PG8_LDB(B1, 1, 1); PG8_STAGE(PG8_SB(1, 0), b3, voffB);
            PG8_BAR; PG8_WAIT_L(0); PG8_MMA(0, 1, At, B1); PG8_BAR;
            PG8_LDA(At, 1, 1); PG8_STAGE(PG8_SA(1, 0), a3, voffA);
            PG8_BAR; PG8_WAIT_L(0); PG8_MMA(1, 0, At, B0); PG8_BAR; PG8_SCHED;
            PG8_STAGE(PG8_SB(1, 1), b3 + hstep, voffB);
            PG8_WAIT_V(6); PG8_BAR; PG8_MMA(1, 1, At, B1); PG8_BAR;
            }
        }
        if constexpr (ALIGN_EPI) { if (wr == 0) PG8_BAR; }
        if constexpr (!Epi::AFTER_DRAIN) { E(acc, cur, wr, wc, fr, fq); S.done(cur); }
        if (!has_next) break;
#pragma unroll
        for (int a = 0; a < 2; ++a)
#pragma unroll
            for (int b = 0; b < 2; ++b)
#pragma unroll
                for (int m = 0; m < 4; ++m)
#pragma unroll
                    for (int n = 0; n < 2; ++n) acc[a][b][m][n] = (f32x4){0.f, 0.f, 0.f, 0.f};
        cur = nxt; cA = nA; cB = nB; ++ui;
        if constexpr (ALIGN_EPI) { if (wr == 1) PG8_BAR; }
    }
    PG8_WAIT_V(0);
    if constexpr (!ALIGN_EPI) { if (wr == 0) PG8_BAR; }
    PG8_BAR;
    if constexpr (Epi::AFTER_DRAIN) { E.fused(acc, cur, wr, wc, fr, fq, lds, wid, lane); S.done(cur); }
#undef PG8_SA
#undef PG8_SB
#undef PG8_STAGE
#undef PG8_LDA
#undef PG8_LDB
#undef PG8_MMA
#undef PG8_WAIT_V
#undef PG8_WAIT_L
#undef PG8_BAR
#undef PG8_SCHED
}
}
#define GAS __attribute__((address_space(1)))
#define LAS __attribute__((address_space(3)))
typedef unsigned short bf16;
typedef unsigned v4u __attribute__((ext_vector_type(4)));
typedef float f32x4 __attribute__((ext_vector_type(4)));
typedef short bf16x8 __attribute__((ext_vector_type(8)));
typedef GAS unsigned gu32;
typedef GAS unsigned long long gu64;
#define RLX_AGENT __ATOMIC_RELAXED, __HIP_MEMORY_SCOPE_AGENT
#define LDS_WAIT() asm volatile("s_waitcnt lgkmcnt(0)" ::: "memory")
#define VM_WAIT() asm volatile("s_waitcnt vmcnt(0)" ::: "memory")
__device__ __forceinline__ unsigned long long rt() { return __builtin_amdgcn_s_memrealtime(); }
__device__ __forceinline__ unsigned f2bf(float f) { unsigned u = __builtin_bit_cast(unsigned, f); return (u + 0x7fffu + ((u >> 16) & 1u)) >> 16; }
__device__ __forceinline__ unsigned pk2(float lo, float hi) { return f2bf(lo) | (f2bf(hi) << 16); }
#define XB_TMO      128
#define XB_XCNT(j)  (256  + 64 * (j))
#define XB_XSUB(j)  (1280 + 64 * (j))
#define XB_XGEN(j)  (2304 + 64 * (j))
#define XB_TOP      3328
#define XB_TOPGEN   3392
#define XCD_BAR_WORDS 3456
#define XB_SPIN_CAP (1u << 24)

__device__ __forceinline__ unsigned xb_ld(unsigned* p)              { return __hip_atomic_load(p, __ATOMIC_RELAXED, __HIP_MEMORY_SCOPE_AGENT); }
__device__ __forceinline__ unsigned xb_add(unsigned* p, unsigned v) { return __hip_atomic_fetch_add(p, v, __ATOMIC_RELAXED, __HIP_MEMORY_SCOPE_AGENT); }
__device__ __forceinline__ unsigned xb_xcc_id() { return (unsigned)__builtin_amdgcn_s_getreg((3 << 11) | 20) & 0xFu; }
#define XB_SPIN(cond, bar) do { unsigned _sp = 0; while (cond) { __builtin_amdgcn_s_sleep(1); \
    if ((++_sp & 255u) == 0u) { if (xb_ld(&(bar)[XB_TMO])) break; if (_sp > XB_SPIN_CAP) { atomicAdd(&(bar)[XB_TMO], 1u); break; } } } } while (0)

struct XcdBarrier {
    unsigned* bar; unsigned x;
    volatile LAS unsigned* st;
};

__device__ __forceinline__ XcdBarrier xcd_barrier_post(unsigned* bar, volatile LAS unsigned* st) {
    XcdBarrier b; b.bar = bar; b.x = xb_xcc_id(); b.st = st;
    if (threadIdx.x == 0) (void)xb_add(&bar[XB_XCNT(b.x)], 1u);
    return b;
}
__device__ __forceinline__ void xcd_barrier_complete(unsigned* bar, unsigned x, unsigned& nloc, unsigned& nx) {
    const unsigned G = gridDim.x * gridDim.y * gridDim.z;
    unsigned sum, cnt, mine, sp = 0u;
    for (;;) {
        sum = 0u; cnt = 0u; mine = 0u;
#pragma unroll
        for (unsigned j = 0; j < 16; ++j) { const unsigned c = xb_ld(&bar[XB_XCNT(j)]); sum += c; cnt += (c > 0u) ? 1u : 0u; mine = (j == x) ? c : mine; }
        if (sum == G) break;
        __builtin_amdgcn_s_sleep(1);
        if ((++sp & 255u) == 0u) { if (xb_ld(&bar[XB_TMO])) break; if (sp > XB_SPIN_CAP) { atomicAdd(&bar[XB_TMO], 1u); break; } }
    }
    nloc = mine > 0u ? mine : 1u; nx = cnt > 0u ? cnt : 1u;
}

__device__ __forceinline__ void xcd_barrier(const XcdBarrier& b) {
    asm volatile("s_waitcnt vmcnt(0)" ::: "memory");
    __syncthreads();
    if (threadIdx.x == 0) {
        unsigned* bar = b.bar;
        __builtin_amdgcn_s_waitcnt(0);
        unsigned nloc = b.st[0], nx = b.st[1];
        if (nloc == 0u) { xcd_barrier_complete(bar, b.x, nloc, nx); b.st[0] = nloc; b.st[1] = nx; }
        const unsigned old = xb_add(&bar[XB_XSUB(b.x)], 1u);
        const unsigned gen = old / nloc;
        if (old + 1u == (gen + 1u) * nloc) {
            __builtin_amdgcn_fence(__ATOMIC_RELEASE, "agent");
            asm volatile("s_waitcnt vmcnt(0)" ::: "memory");
            const unsigned og = xb_add(&bar[XB_TOP], 1u);
            const unsigned tg = og / nx;
            if (og + 1u == (tg + 1u) * nx) xb_add(&bar[XB_TOPGEN], 1u);
            else XB_SPIN(xb_ld(&bar[XB_TOPGEN]) == tg, bar);
            __builtin_amdgcn_fence(__ATOMIC_ACQUIRE, "agent");
            xb_add(&bar[XB_XGEN(b.x)], 1u);
            asm volatile("s_waitcnt vmcnt(0)" ::: "memory");
        } else {
            XB_SPIN(xb_ld(&bar[XB_XGEN(b.x)]) == gen, bar);
            __builtin_amdgcn_fence(__ATOMIC_ACQUIRE, "agent");
            asm volatile("s_waitcnt vmcnt(0)" ::: "memory");
        }
    }
    __syncthreads();
}
namespace sba {
using bf16x8 = __attribute__((ext_vector_type(8))) short;
using s16x4 = __attribute__((ext_vector_type(4))) short;
using f32x16 = __attribute__((ext_vector_type(16))) float;
using u32x4 = __attribute__((ext_vector_type(4))) unsigned;
typedef unsigned short bf16;
constexpr int SEQ = 8192, D = 64, PITCH = 512, NW = 8, QBLK = 32, QB = 256, KVBLK = 64;
constexpr int NSLOT = 3, SLOTB = 8192;
constexpr int LDS_K = 0, LDS_V = NSLOT * SLOTB, LDS_OST = 2 * NSLOT * SLOTB, LDS_BYTES = LDS_OST + NW * 4096;
__device__ __forceinline__ int crow(int r, int hi) { return (r & 3) + 8 * (r >> 2) + 4 * hi; }
__device__ __forceinline__ void glds16(const void* gsrc, unsigned lds_dst) { unsigned keep;
    asm volatile("s_mov_b32 %0, m0\n\ts_mov_b32 m0, %2\n\ts_nop 0\n\tglobal_load_lds_dwordx4 %1, off\n\ts_mov_b32 m0, %0" : "=&s"(keep) : "v"(gsrc), "s"(lds_dst) : "memory"); }
typedef float f32x2_t __attribute__((ext_vector_type(2))); typedef __bf16 bf16x2_t __attribute__((ext_vector_type(2)));
__device__ __forceinline__ unsigned cvtpk(float lo, float hi) { f32x2_t v = {lo, hi}; bf16x2_t b = __builtin_convertvector(v, bf16x2_t); return __builtin_bit_cast(unsigned, b); }
typedef __attribute__((address_space(3))) const char* lds_cptr;
typedef short v4i16_t __attribute__((ext_vector_type(4)));
__device__ __forceinline__ s16x4 vtr(lds_cptr p) { return __builtin_bit_cast(s16x4, __builtin_amdgcn_ds_read_tr16_b64_v4i16((__attribute__((address_space(3))) v4i16_t*)p)); }
#define SBA_WAIT_BAR(N) asm volatile("s_waitcnt vmcnt(" #N ") lgkmcnt(0)\n\ts_barrier" ::: "memory")

__device__ __forceinline__ void qkt(f32x16& p0, f32x16& p1, lds_cptr kb, const bf16x8* qr, const f32x16& cinit) {
#pragma unroll
    for (int d0 = 0; d0 < 4; ++d0) {
        const bf16x8 b0 = *(const __attribute__((address_space(3))) bf16x8*)(kb + d0 * 2048);
        const bf16x8 b1 = *(const __attribute__((address_space(3))) bf16x8*)(kb + d0 * 2048 + 512);
        if (d0 == 0) { p0 = __builtin_amdgcn_mfma_f32_32x32x16_bf16(b0, qr[0], cinit, 0, 0, 0); p1 = __builtin_amdgcn_mfma_f32_32x32x16_bf16(b1, qr[0], cinit, 0, 0, 0); }
        else { p0 = __builtin_amdgcn_mfma_f32_32x32x16_bf16(b0, qr[d0], p0, 0, 0, 0); p1 = __builtin_amdgcn_mfma_f32_32x32x16_bf16(b1, qr[d0], p1, 0, 0, 0); } }
}
__device__ __forceinline__ void pv(f32x16* o, lds_cptr vp, bf16x8 pa0, bf16x8 pa1, bf16x8 pa2, bf16x8 pa3) {
#pragma unroll
    for (int d0 = 0; d0 < 2; ++d0) { s16x4 lo[4], hi[4];
#pragma unroll
        for (int ks = 0; ks < 4; ++ks) { lo[ks] = vtr(vp + d0 * 4096 + ks * 1024); hi[ks] = vtr(vp + d0 * 4096 + ks * 1024 + 512); }
#define SBA_PK(k) (bf16x8){lo[k][0], lo[k][1], lo[k][2], lo[k][3], hi[k][0], hi[k][1], hi[k][2], hi[k][3]}
        o[d0] = __builtin_amdgcn_mfma_f32_32x32x16_bf16(pa0, SBA_PK(0), o[d0], 0, 0, 0);
        o[d0] = __builtin_amdgcn_mfma_f32_32x32x16_bf16(pa1, SBA_PK(1), o[d0], 0, 0, 0);
        o[d0] = __builtin_amdgcn_mfma_f32_32x32x16_bf16(pa2, SBA_PK(2), o[d0], 0, 0, 0);
        o[d0] = __builtin_amdgcn_mfma_f32_32x32x16_bf16(pa3, SBA_PK(3), o[d0], 0, 0, 0);
#undef SBA_PK
    }
}
__device__ __forceinline__ float sb_block(const f32x16& p, float Din, bool hiLane, u32x4& wA, u32x4& wB) {
    float e[16], a[16];
#pragma unroll
    for (int r = 0; r < 16; ++r) { e[r] = __builtin_amdgcn_exp2f(p[r]); a[r] = 1.0f + e[r]; }
    float own[4], PP[4], f[4];
#pragma unroll
    for (int j = 0; j < 4; ++j) { own[j] = (a[4 * j] * a[4 * j + 1]) * (a[4 * j + 2] * a[4 * j + 3]);
        const auto rr = __builtin_amdgcn_permlane32_swap(__float_as_uint(own[j]), __float_as_uint(own[j]), false, false);
        const float vlo = __uint_as_float(rr[0]), vhi = __uint_as_float(rr[1]);
        PP[j] = vlo * vhi; f[j] = hiLane ? 1.0f : vhi; }
    float base[4]; base[3] = Din; base[2] = base[3] * PP[3]; base[1] = base[2] * PP[2]; base[0] = base[1] * PP[1];
    const float Dout = base[0] * PP[0];
    float w[16];
#pragma unroll
    for (int j = 0; j < 4; ++j) { const float C = base[j] * f[j]; const float R0 = __builtin_amdgcn_rcpf(C * own[j]);
        w[4 * j] = e[4 * j] * R0; float t = R0 * a[4 * j]; w[4 * j + 1] = e[4 * j + 1] * t; t *= a[4 * j + 1]; w[4 * j + 2] = e[4 * j + 2] * t; t *= a[4 * j + 2]; w[4 * j + 3] = e[4 * j + 3] * t; }
    wA = (u32x4){cvtpk(w[0], w[1]), cvtpk(w[2], w[3]), cvtpk(w[4], w[5]), cvtpk(w[6], w[7])};
    wB = (u32x4){cvtpk(w[8], w[9]), cvtpk(w[10], w[11]), cvtpk(w[12], w[13]), cvtpk(w[14], w[15])};
    return Dout;
}
__device__ __forceinline__ void unit(int b, int h, int qb, const bf16* Q, const bf16* __restrict__ K, const bf16* __restrict__ V, bf16* O, float biasl, char* shm) {
    const int tid = threadIdx.x, lane = tid & 63, r32 = lane & 31, hi = lane >> 5; const int wid = __builtin_amdgcn_readfirstlane(tid >> 6);
    const long rowbase = (long)b * SEQ; const int q0 = qb * QB, NT = (q0 + QB) / KVBLK;
    const bf16* Qw = Q + (rowbase + q0 + wid * QBLK) * PITCH + h * D;
    const bf16* Kh = K + rowbase * PITCH + h * D; const bf16* Vh = V + rowbase * PITCH + h * D;
    const unsigned lds0 = (unsigned)(uintptr_t)shm;
    const bf16* ksrc = Kh + (long)lane * PITCH + wid * 8;
    const bf16* vsrc = Vh + (long)(16 * (wid & 3) + (lane >> 2)) * PITCH + (wid >> 2) * 32 + (lane & 3) * 8;
    const unsigned kdst = lds0 + LDS_K + wid * 1024, vdst = lds0 + LDS_V + wid * 1024;
#define SBA_DMA(t, slot) do { glds16(ksrc + (long)(t) * KVBLK * PITCH, (unsigned)__builtin_amdgcn_readfirstlane(kdst + (slot))); glds16(vsrc + (long)(t) * KVBLK * PITCH, (unsigned)__builtin_amdgcn_readfirstlane(vdst + (slot))); } while (0)
    const lds_cptr shm3 = (lds_cptr)shm; const lds_cptr kp0 = shm3 + LDS_K + hi * 1024 + r32 * 16;
    const lds_cptr vp0 = shm3 + LDS_V + ((lane >> 4) & 1) * 32 + (lane & 3) * 8 + (4 * hi + ((lane & 15) >> 2)) * 64;
    bf16x8 qr[4];
#pragma unroll
    for (int d0 = 0; d0 < 4; ++d0) qr[d0] = *reinterpret_cast<const bf16x8*>(&Qw[(long)r32 * PITCH + d0 * 16 + hi * 8]);
    SBA_DMA(NT - 1, 0); SBA_DMA(NT - 2, SLOTB);
    f32x16 o[2]; o[0] = f32x16{}; o[1] = f32x16{};
    f32x16 cinit;
#pragma unroll
    for (int r = 0; r < 16; ++r) cinit[r] = biasl;
    float Dc = 1.0f;
    const int qrel = wid * QBLK + r32;
    int slot = 0;
    for (int i = 0; i < NT; ++i) {
        const int t = NT - 1 - i;
        if (i + 1 < NT) SBA_WAIT_BAR(2); else SBA_WAIT_BAR(0);
        if (i + 2 < NT) { const int s2 = slot >= SLOTB ? slot - SLOTB : slot + 2 * SLOTB; SBA_DMA(t - 2, s2); }
        const int jb = t - (NT - 4);
        const bool skip = jb >= 0 && 64 * jb >= 32 * wid + 32;
        if (!skip) {
            f32x16 p0, p1;
            qkt(p0, p1, kp0 + slot, qr, cinit);
            if (jb >= 0 && 64 * jb + 63 >= 32 * wid) {
                const int kb = 64 * jb + 4 * hi;
#pragma unroll
                for (int r = 0; r < 16; ++r) { const int kv = kb + (r & 3) + 8 * (r >> 2); if (kv >= qrel) p0[r] = -INFINITY; if (kv + 32 >= qrel) p1[r] = -INFINITY; }
            }
            u32x4 w0, w1, w2, w3;
            const float Dm = sb_block(p1, Dc, hi != 0, w2, w3);
            Dc = sb_block(p0, Dm, hi != 0, w0, w1);
            pv(o, vp0 + slot, __builtin_bit_cast(bf16x8, w0), __builtin_bit_cast(bf16x8, w1), __builtin_bit_cast(bf16x8, w2), __builtin_bit_cast(bf16x8, w3));
        }
        slot = slot == (NSLOT - 1) * SLOTB ? 0 : slot + SLOTB;
    }
    bf16* Ow = O + (rowbase + q0 + wid * QBLK) * PITCH + h * D;
    { bf16* stg = (bf16*)(shm + LDS_OST) + wid * 2048;
#pragma unroll
      for (int r = 0; r < 16; ++r) { const int orow = crow(r, hi);
#pragma unroll
          for (int d0 = 0; d0 < 2; ++d0) stg[orow * 64 + d0 * 32 + r32] = (bf16)(cvtpk(o[d0][r], 0.f) & 0xffffu); }
      asm volatile("s_waitcnt lgkmcnt(0)" ::: "memory");
#pragma unroll
      for (int i = 0; i < 4; ++i) { const int row = i * 8 + (lane >> 3), ch = lane & 7; const u32x4 v = *(const u32x4*)(stg + row * 64 + ch * 8); *(u32x4*)(Ow + (long)row * PITCH + ch * 8) = v; } }
    asm volatile("s_waitcnt lgkmcnt(0)\n\ts_barrier" ::: "memory");
#undef SBA_DMA
}
#undef SBA_WAIT_BAR

constexpr int SMP_LDS_PER_WAVE = 8192;
typedef float f32x4s __attribute__((ext_vector_type(4)));
typedef unsigned u32x2s __attribute__((ext_vector_type(2)));
__device__ __forceinline__ void sample_group(int b, int g, const bf16* Q, const float* __restrict__ ck, const float* __restrict__ cv, const int* __restrict__ pt,
                                             float biasl, float* PT, float* PO, char* shm, int q_row0) {
    const int tid = threadIdx.x, lane = tid & 63, r32 = lane & 31, hi = lane >> 5; const int h = __builtin_amdgcn_readfirstlane(tid >> 6);
    typedef __attribute__((address_space(3))) char* lds_ptr;
    const lds_ptr kimg = (lds_ptr)shm + h * SMP_LDS_PER_WAVE, vimg = kimg + 4096;
    const lds_cptr kp0 = (lds_cptr)kimg + hi * 512 + r32 * 16;
    const lds_cptr vp0 = (lds_cptr)vimg + ((lane >> 4) & 1) * 32 + (lane & 3) * 8 + (4 * hi + ((lane & 15) >> 2)) * 64;
    const int lrow = lane >> 4, lc = lane & 15;
    const int kwoff = (lc >> 1) * 512 + (lc & 1) * 8, vwoff = (lc >> 3) * 2048 + (lc & 7) * 8;
    bf16x8 qr[4];
#pragma unroll
    for (int d0 = 0; d0 < 4; ++d0) { qr[d0] = bf16x8{}; if (r32 < 8) qr[d0] = *reinterpret_cast<const bf16x8*>(&Q[(long)(q_row0 + b * 8 + r32) * PITCH + h * D + d0 * 16 + hi * 8]); }
    f32x16 o[2]; o[0] = f32x16{}; o[1] = f32x16{};
    f32x16 cinit;
#pragma unroll
    for (int r = 0; r < 16; ++r) cinit[r] = biasl;
    float Dc = 1.0f;
    f32x4s kreg[8], vreg[8];
    auto issue = [&](int ht) { const int page = pt[b * 64 + g * 8 + 7 - (ht >> 2)]; const int r0 = (3 - (ht & 3)) * 32;
        const float* kb = ck + ((long)page * 128 + r0 + lrow) * 512 + h * 64 + lc * 4; const float* vb = cv + ((long)page * 128 + r0 + lrow) * 512 + h * 64 + lc * 4;
#pragma unroll
        for (int i = 0; i < 8; ++i) { kreg[i] = __builtin_nontemporal_load((const f32x4s*)(kb + (long)i * 4 * 512)); vreg[i] = __builtin_nontemporal_load((const f32x4s*)(vb + (long)i * 4 * 512)); } };
    issue(0);
    for (int ht = 0; ht < 32; ++ht) {
#pragma unroll
        for (int i = 0; i < 8; ++i) { const int row = 4 * i + lrow;
            *(__attribute__((address_space(3))) u32x2s*)(kimg + kwoff + row * 16) = (u32x2s){cvtpk(kreg[i][0], kreg[i][1]), cvtpk(kreg[i][2], kreg[i][3])};
            *(__attribute__((address_space(3))) u32x2s*)(vimg + vwoff + row * 64) = (u32x2s){cvtpk(vreg[i][0], vreg[i][1]), cvtpk(vreg[i][2], vreg[i][3])}; }
        if (ht + 1 < 32) issue(ht + 1);
        f32x16 p0;
#pragma unroll
        for (int d0 = 0; d0 < 4; ++d0) { const bf16x8 kf = *(const __attribute__((address_space(3))) bf16x8*)(kp0 + d0 * 1024);
            p0 = __builtin_amdgcn_mfma_f32_32x32x16_bf16(kf, qr[d0], d0 == 0 ? cinit : p0, 0, 0, 0); }
        u32x4 w0, w1;
        Dc = sb_block(p0, Dc, hi != 0, w0, w1);
#pragma unroll
        for (int d0 = 0; d0 < 2; ++d0) { s16x4 lo[2], hh[2];
#pragma unroll
            for (int ks = 0; ks < 2; ++ks) { lo[ks] = vtr(vp0 + d0 * 2048 + ks * 1024); hh[ks] = vtr(vp0 + d0 * 2048 + ks * 1024 + 512); }
            o[d0] = __builtin_amdgcn_mfma_f32_32x32x16_bf16(__builtin_bit_cast(bf16x8, w0), (bf16x8){lo[0][0], lo[0][1], lo[0][2], lo[0][3], hh[0][0], hh[0][1], hh[0][2], hh[0][3]}, o[d0], 0, 0, 0);
            o[d0] = __builtin_amdgcn_mfma_f32_32x32x16_bf16(__builtin_bit_cast(bf16x8, w1), (bf16x8){lo[1][0], lo[1][1], lo[1][2], lo[1][3], hh[1][0], hh[1][1], hh[1][2], hh[1][3]}, o[d0], 0, 0, 0); }
        asm volatile("" ::: "memory");
    }
    const long pb = ((long)((b * 8 + h) * 8) ) * 8 + g;
#pragma unroll
    for (int r = 0; r < 4; ++r) { const int q = r + 4 * hi;
#pragma unroll
        for (int d0 = 0; d0 < 2; ++d0) PO[(pb + (long)q * 8) * 64 + d0 * 32 + r32] = o[d0][r]; }
    if (hi == 0 && r32 < 8) PT[pb + (long)r32 * 8] = Dc;
}
}
constexpr int NWAVES = 8;
#ifndef GEMM_ALIGN
#define GEMM_ALIGN true
#endif
#ifndef GEMM_SP2
#define GEMM_SP2 true
#endif
constexpr int DM = 1024, SEQ = 8192, NB = 2, MP = NB * SEQ, DB = 32, DL = 8, MS = DB * DL, MT = MP + MS;
constexpr int DCONV = 512, NH = 8, HD = 64, DATT = 512, DFF = 4096, DIN = 5120, PAGE = 128, NPAGES = 64;
constexpr float RMS_EPS = 1e-6f, LOG2E = 1.4426950408889634f, C2 = 0.125f * LOG2E;
using pg8::OFF_Y; using pg8::OFF_KP; using pg8::OFF_VP; using pg8::OFF_CP; using pg8::OFF_KS; using pg8::OFF_VS; using pg8::OFF_CS;
constexpr size_t OUT_ELEMS = 34113536;

constexpr size_t MiB = 1u << 20;
constexpr size_t WS_CTL = 0, CTL_ZERO_BYTES = 1 * MiB;
constexpr size_t WS_WIN = 2 * MiB, WS_WPC = 12 * MiB, WS_WPA = 13 * MiB, WS_WOUT = 14 * MiB, WS_WUP = 16 * MiB, WS_WDN = 24 * MiB;
constexpr size_t WS_H = 32 * MiB;
constexpr size_t WS_CU = 66 * MiB;
constexpr size_t WS_BG = 84 * MiB;
constexpr size_t WS_Q = 102 * MiB, WS_K = 120 * MiB, WS_V = 138 * MiB;
constexpr size_t WS_SGC = 156 * MiB, WS_SGA = 190 * MiB;
constexpr size_t WS_BC = 224 * MiB;
constexpr size_t WS_O = 242 * MiB;
constexpr size_t WS_T1 = 260 * MiB;
constexpr size_t WS_MG = 294 * MiB;
constexpr size_t WS_X1 = 328 * MiB;
constexpr size_t WS_G = 394 * MiB;
constexpr size_t WS_PT = 526 * MiB;
constexpr size_t WS_PO = 527 * MiB;
constexpr size_t WS_CGS = 560 * MiB, WS_US = 561 * MiB;
constexpr size_t WS_END = 562 * MiB;
constexpr int CW_BAR = 4096;
static_assert(WS_Q - WS_BG == 18 * MiB && WS_K - WS_Q == 18 * MiB && WS_V - WS_K == 18 * MiB, "EpiProj addresses BG|Q|K|V by stride");

constexpr int RING_OFF = 0, RING_BYTES = 131072;
constexpr int LDSCTL_OFF = RING_BYTES, MISC_OFF = LDSCTL_OFF + 320;
constexpr int LDS_BYTES = 147456;

struct Args {
    const float *xp, *xs, *ck, *cv, *sc; const int* pt; const float *n1w, *win, *cw, *wpc, *wpa, *ab, *wout, *n2w, *wup, *wdn, *nfw;
    float* out; unsigned char* ws; int ph_lo, ph_hi;
};
struct Frame {
    LAS unsigned char* lds; volatile LAS unsigned* MISC; gu32* ctl;
    int tid, lane, wave, vcu, G;
};

__device__ __forceinline__ float wave_sum(float v) {
#pragma unroll
    for (int o = 1; o < 64; o <<= 1) v += __shfl_xor(v, o);
    return v;
}
__device__ __forceinline__ int win_src_col(int vc) {
    const int u = vc >> 8, r = vc & 255;
    if (u < 4) return (r < 128) ? 512 + 128 * u + r : 1024 + 128 * u + (r - 128);
    if (u < 6) return 256 * (u - 4) + r;
    if (u < 12) return 1536 + 256 * (u - 6) + r;
    return 3072 + 256 * (u - 12) + r;
}
__device__ __forceinline__ void transpose_item(const float* W, int K, int N, bf16* WT, LAS float* scr, int kb, int nb, int src_n0, int lane) {
    const int k0 = 64 * kb, n0 = 32 * nb;
#pragma unroll 8
    for (int i = 0; i < 32; ++i) { const int kk = 2 * i + (lane >> 5); scr[kk * 33 + (lane & 31)] = W[(size_t)(k0 + kk) * N + src_n0 + (lane & 31)]; }
    LDS_WAIT(); asm volatile("" ::: "memory");
    const int c = lane & 7;
#pragma unroll
    for (int j = 0; j < 4; ++j) { const int n = (lane >> 3) + 8 * j; const LAS float* s = scr + (8 * c) * 33 + n;
        v4u o; o.x = pk2(s[0 * 33], s[1 * 33]); o.y = pk2(s[2 * 33], s[3 * 33]); o.z = pk2(s[4 * 33], s[5 * 33]); o.w = pk2(s[6 * 33], s[7 * 33]);
        *(GAS v4u*)(WT + (size_t)(n0 + n) * K + k0 + 8 * c) = o; }
    LDS_WAIT(); asm volatile("" ::: "memory");
}
__device__ __forceinline__ void rms_row_to_bf16(int lane, const float* xrow, const float* w, bf16* orow) {
    const GAS f32x4* xr = (const GAS f32x4*)xrow + lane; const GAS f32x4* wr = (const GAS f32x4*)w + lane;
    f32x4 v[4]; float s = 0.f;
#pragma unroll
    for (int j = 0; j < 4; ++j) { v[j] = xr[64 * j]; s += (v[j].x * v[j].x + v[j].y * v[j].y) + (v[j].z * v[j].z + v[j].w * v[j].w); }
    const float rstd = 1.0f / sqrtf(wave_sum(s) * (1.f / DM) + RMS_EPS);
    GAS unsigned long long* o8 = (GAS unsigned long long*)orow + lane;
#pragma unroll
    for (int j = 0; j < 4; ++j) { const f32x4 g = wr[64 * j]; o8[64 * j] = (unsigned long long)pk2(v[j].x * rstd * g.x, v[j].y * rstd * g.y) | ((unsigned long long)pk2(v[j].z * rstd * g.z, v[j].w * rstd * g.w) << 32); }
}
__device__ __forceinline__ void rms_row_to_f32(int lane, const float* xrow, const float* w, float* orow, bool poison) {
    const GAS f32x4* xr = (const GAS f32x4*)xrow + lane; const GAS f32x4* wr = (const GAS f32x4*)w + lane;
    f32x4 v[4]; float s = 0.f;
#pragma unroll
    for (int j = 0; j < 4; ++j) { v[j] = xr[64 * j]; s += (v[j].x * v[j].x + v[j].y * v[j].y) + (v[j].z * v[j].z + v[j].w * v[j].w); }
    float rstd = 1.0f / sqrtf(wave_sum(s) * (1.f / DM) + RMS_EPS); if (poison) rstd = __builtin_nanf("");
    GAS f32x4* o = (GAS f32x4*)orow + lane;
#pragma unroll
    for (int j = 0; j < 4; ++j) { const f32x4 g = wr[64 * j]; o[64 * j] = v[j] * rstd * g; }
}
__device__ __forceinline__ float bf2f(unsigned short b) { return __uint_as_float((unsigned)b << 16); }


typedef float f32x16m __attribute__((ext_vector_type(16)));
template <class Epi> __device__ __forceinline__ void skinny_gemm(const bf16* A, const bf16* Bt, int N, int K, const Epi& E, LAS unsigned char* ldsb, int first, int stride) {
    const int tid = threadIdx.x, lane = tid & 63, r32 = lane & 31, hi = lane >> 5; const int wid = __builtin_amdgcn_readfirstlane(tid >> 6);
    const int ntiles = 8 * (N >> 5), kw = K >> 3, k0 = wid * kw;
    LAS float* red = (LAS float*)ldsb;
    for (int tl = first; tl < ntiles; tl += stride) {
        const int row0 = (tl & 7) * 32, col0 = (tl >> 3) * 32;
        const bf16* ap = A + (size_t)(row0 + r32) * K + k0 + 8 * hi; const bf16* bp = Bt + (size_t)(col0 + r32) * K + k0 + 8 * hi;
        f32x16m acc = {};
#pragma unroll 8
        for (int k = 0; k < kw; k += 16) { const bf16x8 a = *(const bf16x8*)(ap + k), b = *(const bf16x8*)(bp + k); acc = __builtin_amdgcn_mfma_f32_32x32x16_bf16(a, b, acc, 0, 0, 0); }
#pragma unroll
        for (int r = 0; r < 16; ++r) red[(wid * 16 + r) * 64 + lane] = acc[r];
        __syncthreads();
#pragma unroll
        for (int h2 = 0; h2 < 2; ++h2) { const int rr = wid + 8 * h2; float sum = 0.f;
#pragma unroll
            for (int w = 0; w < 8; ++w) sum += red[(w * 16 + rr) * 64 + lane];
            E(row0 + (rr & 3) + 8 * (rr >> 2) + 4 * hi, col0 + r32, sum); }
        __syncthreads();
    }
}
struct SkProj {
    float *CGs, *Us; bf16 *BG, *SGC, *SGA; float* out; float qscale;
    __device__ __forceinline__ void operator()(int srow, int vc, float v) const {
        const int u = vc >> 8, r = vc & 255; const size_t row = (size_t)MP + srow;
        if (u < 4) { if (r < 128) CGs[srow * 512 + 128 * u + r] = v; else Us[srow * 512 + 128 * u + r - 128] = v; }
        else if (u < 12) { const int kind = (u - 4) >> 1, col = ((u - 4) & 1) * 256 + r; if (kind == 1) v *= qscale;
            (BG + (size_t)kind * (size_t)(18u << 19))[row * 512 + col] = (bf16)f2bf(v);
            if (kind == 2) out[OFF_KS + (size_t)srow * 512 + col] = v; if (kind == 3) out[OFF_VS + (size_t)srow * 512 + col] = v; }
        else { bf16* dst = u < 16 ? SGC : SGA; const int col = ((u - 12) & 3) * 256 + r; dst[row * 1024 + col] = (bf16)f2bf(pg8::sigmoidf_fast(v)); }
    }
};
template <int MODE> struct SkBf {
    bf16* O; int ldc; const bf16* G1; const bf16* ADD;
    __device__ __forceinline__ void operator()(int srow, int col, float v) const { const size_t i = (size_t)srow * ldc + col;
        if (MODE == 0 || MODE == 1) v *= bf2f(G1[i]); if (MODE == 1) v += bf2f(ADD[i]); if (MODE == 2) { v = fmaxf(v, 0.f); v *= v; }
        O[i] = (bf16)f2bf(v); }
};
struct SkRes {
    const float* base; float* out;
    __device__ __forceinline__ void operator()(int srow, int col, float v) const { const size_t i = (size_t)srow * 1024 + col; out[i] = base[i] + v; }
};

__global__ void __launch_bounds__(NWAVES * 64, 2) hybrid_fwd(Args args) {
    extern __shared__ __attribute__((aligned(16))) unsigned char lds[];
    Frame F;
    F.lds = (LAS unsigned char*)lds;
    F.MISC = (volatile LAS unsigned*)(F.lds + MISC_OFF);
    F.tid = threadIdx.x; F.lane = F.tid & 63; F.wave = __builtin_amdgcn_readfirstlane(F.tid >> 6);
    F.G = gridDim.x; { const int bx = blockIdx.x; F.vcu = (F.G % 8 == 0) ? (bx % 8) * (F.G / 8) + bx / 8 : bx; }
    unsigned char* ws = args.ws;
    F.ctl = (gu32*)(ws + WS_CTL);
    bf16* const Win_t = (bf16*)(ws + WS_WIN); bf16* const Wpc_t = (bf16*)(ws + WS_WPC); bf16* const Wpa_t = (bf16*)(ws + WS_WPA);
    bf16* const Wout_t = (bf16*)(ws + WS_WOUT); bf16* const Wup_t = (bf16*)(ws + WS_WUP); bf16* const Wdn_t = (bf16*)(ws + WS_WDN);
    bf16* const HB = (bf16*)(ws + WS_H); bf16* const CUB = (bf16*)(ws + WS_CU); bf16* const BGB = (bf16*)(ws + WS_BG);
    bf16* const QB = (bf16*)(ws + WS_Q); bf16* const KB = (bf16*)(ws + WS_K); bf16* const VB = (bf16*)(ws + WS_V);
    bf16* const SGC = (bf16*)(ws + WS_SGC); bf16* const SGA = (bf16*)(ws + WS_SGA); bf16* const BCB = (bf16*)(ws + WS_BC); bf16* const OB = (bf16*)(ws + WS_O);
    bf16* const T1 = (bf16*)(ws + WS_T1); bf16* const MG = (bf16*)(ws + WS_MG); float* const X1 = (float*)(ws + WS_X1); bf16* const GB = (bf16*)(ws + WS_G);
    float* const PT = (float*)(ws + WS_PT); float* const PO = (float*)(ws + WS_PO); float* const CGs = (float*)(ws + WS_CGS); float* const Us = (float*)(ws + WS_US);
    for (int u = F.tid; u < (LDS_BYTES - LDSCTL_OFF) / 4; u += NWAVES * 64) ((LAS unsigned*)(F.lds + LDSCTL_OFF))[u] = 0u;
    __syncthreads();
    XcdBarrier bar = xcd_barrier_post((unsigned*)(F.ctl + CW_BAR), F.MISC + 8);
    const int gw = F.vcu * NWAVES + F.wave, NGW = F.G * NWAVES;
    const int gtid = blockIdx.x * (NWAVES * 64) + F.tid, NGT = F.G * NWAVES * 64;

    const int lo = args.ph_lo, hi = args.ph_hi;
#define IN(k) (lo <= (k) && (k) < hi)
#define SEAM(k) do { if (IN(k) && IN((k) + 1)) xcd_barrier(bar); } while (0)
    if (IN(0)) {
        LAS float* scr = (LAS float*)(F.lds + RING_OFF + F.wave * 16384);
        constexpr int I_IN = (DM / 64) * (DIN / 32), I_PC = (DCONV / 64) * (DM / 32), I_PA = (DATT / 64) * (DM / 32), I_OUT = (DM / 64) * (DM / 32), I_UP = (DM / 64) * (DFF / 32), I_DN = (DFF / 64) * (DM / 32);
        constexpr int NITEMS = I_IN + I_PC + I_PA + I_OUT + I_UP + I_DN;
        for (int it = gw; it < NITEMS; it += NGW) {
            int r = it;
            if (r < I_IN) { const int nblk = DIN / 32, kb = r / nblk, nb = r % nblk; transpose_item(args.win, DM, DIN, Win_t, scr, kb, nb, win_src_col(32 * nb), F.lane); continue; } r -= I_IN;
            if (r < I_PC) { const int nblk = DM / 32, kb = r / nblk, nb = r % nblk; transpose_item(args.wpc, DCONV, DM, Wpc_t, scr, kb, nb, 32 * nb, F.lane); continue; } r -= I_PC;
            if (r < I_PA) { const int nblk = DM / 32, kb = r / nblk, nb = r % nblk; transpose_item(args.wpa, DATT, DM, Wpa_t, scr, kb, nb, 32 * nb, F.lane); continue; } r -= I_PA;
            if (r < I_OUT) { const int nblk = DM / 32, kb = r / nblk, nb = r % nblk; transpose_item(args.wout, DM, DM, Wout_t, scr, kb, nb, 32 * nb, F.lane); continue; } r -= I_OUT;
            if (r < I_UP) { const int nblk = DFF / 32, kb = r / nblk, nb = r % nblk; transpose_item(args.wup, DM, DFF, Wup_t, scr, kb, nb, 32 * nb, F.lane); continue; } r -= I_UP;
            { const int nblk = DM / 32, kb = r / nblk, nb = r % nblk; transpose_item(args.wdn, DFF, DM, Wdn_t, scr, kb, nb, 32 * nb, F.lane); }
        }
        for (int m = gw; m < MT; m += NGW) rms_row_to_bf16(F.lane, m < MP ? args.xp + (size_t)m * DM : args.xs + (size_t)(m - MP) * DM, args.n1w, HB + (size_t)m * DM);
    }
    SEAM(0);

    if (IN(1)) {
        { SkProj E{CGs, Us, BGB, SGC, SGA, args.out, C2}; skinny_gemm(HB + (size_t)MP * DM, Win_t, DIN, DM, E, F.lds + RING_OFF, F.vcu, F.G); }
        pg8::Gemm g{HB, Win_t, MP, DIN, DM}; pg8::StaticOrder S; S.init(MP, DIN, F.G, (int)blockIdx.x);
        pg8::EpiProj E{CUB, BGB, QB, KB, VB, SGC, SGA, args.out, C2};
        pg8::gemm_phase<pg8::EpiProj, pg8::StaticOrder, GEMM_ALIGN, GEMM_SP2>(F.lds + RING_OFF, g, S, E);
    }
    SEAM(1);

    if (IN(2)) {
        for (int it = gtid; it < MP * 64; it += NGT) {
            const int row = it >> 6, j = (it & 63) * 8, t = row & (SEQ - 1);
            f32x4 c0a, c0b, c1a, c1b, c2a, c2b, ba, bb; const f32x4 z4 = {0.f, 0.f, 0.f, 0.f};
            pg8::unpack8(*(const pg8::u32x4*)(CUB + (size_t)row * 512 + j), c2a, c2b);
            pg8::unpack8(*(const pg8::u32x4*)(BGB + (size_t)row * 512 + j), ba, bb);
            if (t >= 1) pg8::unpack8(*(const pg8::u32x4*)(CUB + (size_t)(row - 1) * 512 + j), c1a, c1b); else { c1a = z4; c1b = z4; }
            if (t >= 2) pg8::unpack8(*(const pg8::u32x4*)(CUB + (size_t)(row - 2) * 512 + j), c0a, c0b); else { c0a = z4; c0b = z4; }
            const f32x4 w0a = *(const f32x4*)(args.cw + j), w0b = *(const f32x4*)(args.cw + j + 4), w1a = *(const f32x4*)(args.cw + 512 + j), w1b = *(const f32x4*)(args.cw + 512 + j + 4),
                        w2a = *(const f32x4*)(args.cw + 1024 + j), w2b = *(const f32x4*)(args.cw + 1024 + j + 4);
            const f32x4 ra = ba * (w0a * c0a + w1a * c1a + w2a * c2a), rb = bb * (w0b * c0b + w1b * c1b + w2b * c2b);
            *(pg8::u32x4*)(BCB + (size_t)row * 512 + j) = pg8::pack8(ra, rb);
        }
        for (int it = gtid; it < MS * 64; it += NGT) {
            const int r = it >> 6, j = (it & 63) * 8, t = r & 7; const float* st = args.sc + (size_t)(r >> 3) * 2 * 512 + j;
            const float* cg = CGs + (size_t)r * 512 + j; const float* uu = Us + (size_t)r * 512 + j;
            const f32x4 c2a = *(const f32x4*)cg * *(const f32x4*)uu, c2b = *(const f32x4*)(cg + 4) * *(const f32x4*)(uu + 4);
            f32x4 c1a, c1b, c0a, c0b, ba, bb;
            if (t >= 1) { c1a = *(const f32x4*)(cg - 512) * *(const f32x4*)(uu - 512); c1b = *(const f32x4*)(cg - 508) * *(const f32x4*)(uu - 508); } else { c1a = *(const f32x4*)(st + 512); c1b = *(const f32x4*)(st + 516); }
            if (t >= 2) { c0a = *(const f32x4*)(cg - 1024) * *(const f32x4*)(uu - 1024); c0b = *(const f32x4*)(cg - 1020) * *(const f32x4*)(uu - 1020); }
            else { const float* s2 = st + (t == 1 ? 512 : 0); c0a = *(const f32x4*)s2; c0b = *(const f32x4*)(s2 + 4); }
            pg8::unpack8(*(const pg8::u32x4*)(BGB + ((size_t)MP + r) * 512 + j), ba, bb);
            const f32x4 w0a = *(const f32x4*)(args.cw + j), w0b = *(const f32x4*)(args.cw + j + 4), w1a = *(const f32x4*)(args.cw + 512 + j), w1b = *(const f32x4*)(args.cw + 512 + j + 4),
                        w2a = *(const f32x4*)(args.cw + 1024 + j), w2b = *(const f32x4*)(args.cw + 1024 + j + 4);
            const f32x4 ra = ba * (w0a * c0a + w1a * c1a + w2a * c2a), rb = bb * (w0b * c0b + w1b * c1b + w2b * c2b);
            *(pg8::u32x4*)(BCB + ((size_t)MP + r) * 512 + j) = pg8::pack8(ra, rb);
            if (t >= 6) { float* cs = args.out + OFF_CS + (size_t)(((r >> 3) * 2 + (t - 6)) * 512 + j); *(f32x4*)cs = c2a; *(f32x4*)(cs + 4) = c2b; }
        }
        for (int v = F.vcu; v < 256; v += F.G) {
            const int bh = v >> 4, sq = v & 15; const float biasl = args.ab[bh & 7] * LOG2E;
            sba::unit(bh >> 3, bh & 7, 31 - sq, QB, KB, VB, OB, biasl, (char*)lds + RING_OFF);
            sba::unit(bh >> 3, bh & 7, sq, QB, KB, VB, OB, biasl, (char*)lds + RING_OFF);
        }
        for (int v = F.vcu; v < 256; v += F.G) sba::sample_group(v >> 3, v & 7, QB, args.ck, args.cv, args.pt, args.ab[F.wave] * LOG2E, PT, PO, (char*)lds + RING_OFF, MP);
    }
    SEAM(2);

    if (IN(3)) {
        for (int item = gtid; item < MS * 8 * 64; item += NGT) {
            const int d = item & 63, i = (item >> 6) & 7, h = (item >> 9) & 7, b = item >> 12;
            const size_t qrow = (size_t)MP + b * 8 + i;
            float Dp = 1.0f, acc = 0.f; const float biasl = args.ab[h] * LOG2E;
            for (int jn = i - 1; jn >= 0; --jn) {
                const size_t krow = (size_t)MP + b * 8 + jn; float dot = 0.f;
                for (int dd = 0; dd < 64; ++dd) dot += bf2f(QB[qrow * 512 + h * 64 + dd]) * bf2f(KB[krow * 512 + h * 64 + dd]);
                const float e = __builtin_amdgcn_exp2f(dot + biasl);
                Dp *= (1.0f + e);
                acc += e * __builtin_amdgcn_rcpf(Dp) * bf2f(VB[krow * 512 + h * 64 + d]);
            }
            const size_t pbase = ((size_t)((b * 8 + h) * 8 + i)) * 8;
            for (int j = 7; j >= 0; --j) { acc += PO[(pbase + j) * 64 + d] * __builtin_amdgcn_rcpf(Dp); Dp *= PT[pbase + j]; }
            OB[qrow * 512 + h * 64 + d] = (bf16)f2bf(acc);
        }
        { SkBf<0> E{T1 + (size_t)MP * DM, DM, SGC + (size_t)MP * DM, nullptr}; skinny_gemm(BCB + (size_t)MP * DCONV, Wpc_t, DM, DCONV, E, F.lds + RING_OFF, F.vcu, F.G); }
        pg8::Gemm g{BCB, Wpc_t, MP, DM, DCONV}; pg8::StaticOrder S; S.init(MP, DM, F.G, (int)blockIdx.x);
        pg8::EpiBf<0> E{T1, DM, SGC, nullptr};
        pg8::gemm_phase<pg8::EpiBf<0>, pg8::StaticOrder, GEMM_ALIGN, GEMM_SP2>(F.lds + RING_OFF, g, S, E);
    }
    SEAM(3);

    if (IN(4)) {
        { SkBf<1> E{MG + (size_t)MP * DM, DM, SGA + (size_t)MP * DM, T1 + (size_t)MP * DM}; skinny_gemm(OB + (size_t)MP * DATT, Wpa_t, DM, DATT, E, F.lds + RING_OFF, F.vcu, F.G); }
        pg8::Gemm g{OB, Wpa_t, MP, DM, DATT}; pg8::StaticOrder S; S.init(MP, DM, F.G, (int)blockIdx.x);
        pg8::EpiBf<1> E{MG, DM, SGA, T1};
        pg8::gemm_phase<pg8::EpiBf<1>, pg8::StaticOrder, GEMM_ALIGN, GEMM_SP2>(F.lds + RING_OFF, g, S, E);
    }
    SEAM(4);

    if (IN(5)) {
        { SkRes E{args.xs, X1 + (size_t)MP * DM}; skinny_gemm(MG + (size_t)MP * DM, Wout_t, DM, DM, E, F.lds + RING_OFF, F.vcu, F.G); }
        pg8::Gemm g{MG, Wout_t, MP, DM, DM}; pg8::StaticOrder S; S.init(MP, DM, F.G, (int)blockIdx.x);
        pg8::EpiResF32 E{args.xp, args.xs, X1};
        pg8::gemm_phase<pg8::EpiResF32, pg8::StaticOrder, GEMM_ALIGN, GEMM_SP2>(F.lds + RING_OFF, g, S, E);
    }
    SEAM(5);

    if (IN(6)) for (int m = gw; m < MT; m += NGW) rms_row_to_bf16(F.lane, X1 + (size_t)m * DM, args.n2w, HB + (size_t)m * DM);
    SEAM(6);

    if (IN(7)) {
        { SkBf<2> E{GB + (size_t)MP * DFF, DFF, nullptr, nullptr}; skinny_gemm(HB + (size_t)MP * DM, Wup_t, DFF, DM, E, F.lds + RING_OFF, F.vcu, F.G); }
        pg8::Gemm g{HB, Wup_t, MP, DFF, DM}; pg8::StaticOrder S; S.init(MP, DFF, F.G, (int)blockIdx.x);
        pg8::EpiBf<2> E{GB, DFF, nullptr, nullptr};
        pg8::gemm_phase<pg8::EpiBf<2>, pg8::StaticOrder, GEMM_ALIGN, GEMM_SP2>(F.lds + RING_OFF, g, S, E);
    }
    SEAM(7);

    if (IN(8)) {
        { SkRes E{X1 + (size_t)MP * DM, args.out + OFF_Y + (size_t)MP * DM}; skinny_gemm(GB + (size_t)MP * DFF, Wdn_t, DM, DFF, E, F.lds + RING_OFF, F.vcu, F.G); }
        pg8::Gemm g{GB, Wdn_t, MP, DM, DFF}; pg8::StaticOrder S; S.init(MP, DM, F.G, (int)blockIdx.x);
        pg8::EpiResF32 E{X1, X1 + (size_t)MP * DM, args.out + OFF_Y};
        pg8::gemm_phase<pg8::EpiResF32, pg8::StaticOrder, GEMM_ALIGN, GEMM_SP2>(F.lds + RING_OFF, g, S, E);
    }
    SEAM(8);

    if (IN(9)) {
    const bool poison = __hip_atomic_load((gu32*)((unsigned*)(F.ctl + CW_BAR) + XB_TMO), RLX_AGENT) != 0u;
    for (int m = gw; m < MT; m += NGW) rms_row_to_f32(F.lane, args.out + OFF_Y + (size_t)m * DM, args.nfw, args.out + OFF_Y + (size_t)m * DM, poison);
    }
#undef IN
#undef SEAM
}

extern "C" void kernel_launch(void* const* d_in, const int* in_sizes, int n_in, void* d_out, int out_size, void* d_ws, size_t ws_size, hipStream_t stream) {
    static int grid = 0;
    if (grid == 0) {
        if (n_in != 17 || (size_t)out_size != OUT_ELEMS || ws_size < WS_END) { fprintf(stderr, "kernel_launch: unexpected problem shape (n_in %d out %d ws %zu)\n", n_in, out_size, ws_size); grid = -1; return; }
        int dev = 0, cus = 0, per_cu = 0;
        if (hipGetDevice(&dev) != hipSuccess || hipDeviceGetAttribute(&cus, hipDeviceAttributeMultiprocessorCount, dev) != hipSuccess) { grid = -1; return; }
        if (hipFuncSetAttribute((const void*)hybrid_fwd, hipFuncAttributeMaxDynamicSharedMemorySize, LDS_BYTES) != hipSuccess) { fprintf(stderr, "kernel_launch: hipFuncSetAttribute failed\n"); grid = -1; return; }
        if (hipOccupancyMaxActiveBlocksPerMultiprocessor(&per_cu, (const void*)hybrid_fwd, NWAVES * 64, LDS_BYTES) != hipSuccess || per_cu < 1) { fprintf(stderr, "kernel_launch: occupancy query says %d\n", per_cu); }
        (void)hipGetLastError();
        grid = cus;
    }
    if (grid < 0) return;
    if (hipMemsetAsync((char*)d_ws + WS_CTL, 0, CTL_ZERO_BYTES, stream) != hipSuccess) return;
    Args a{};
    a.xp = (const float*)d_in[0]; a.xs = (const float*)d_in[1]; a.ck = (const float*)d_in[2]; a.cv = (const float*)d_in[3]; a.sc = (const float*)d_in[4]; a.pt = (const int*)d_in[5];
    a.n1w = (const float*)d_in[6]; a.win = (const float*)d_in[7]; a.cw = (const float*)d_in[8]; a.wpc = (const float*)d_in[9]; a.wpa = (const float*)d_in[10]; a.ab = (const float*)d_in[11];
    a.wout = (const float*)d_in[12]; a.n2w = (const float*)d_in[13]; a.wup = (const float*)d_in[14]; a.wdn = (const float*)d_in[15]; a.nfw = (const float*)d_in[16];
    a.out = (float*)d_out; a.ws = (unsigned char*)d_ws;
    constexpr int NPH = 10;
#ifndef MK_PER_PHASE
#define MK_PER_PHASE 0
#endif
    if (MK_PER_PHASE) { for (int k = 0; k < NPH; ++k) { a.ph_lo = k; a.ph_hi = k + 1; hipLaunchKernelGGL(hybrid_fwd, dim3(grid), dim3(NWAVES * 64), LDS_BYTES, stream, a); } }
    else { a.ph_lo = 0; a.ph_hi = NPH; hipLaunchKernelGGL(hybrid_fwd, dim3(grid), dim3(NWAVES * 64), LDS_BYTES, stream, a); }
}
```

```cpp
#include <hip/hip_runtime.h>
#include <cstdio>
#include <cstdint>
namespace pg8 {
#define PG8_LAS __attribute__((address_space(3)))
typedef unsigned short bf16_t;
typedef short bf16x8 __attribute__((ext_vector_type(8)));
typedef float f32x4 __attribute__((ext_vector_type(4)));
typedef unsigned u32x4 __attribute__((ext_vector_type(4)));
constexpr int BM = 256, BK = 64, HALF = 128, HTB = HALF * BK * 2  , STAGE_BYTES = 8 * HTB, NXCD = 8, WGM = 8;

__host__ __device__ __forceinline__ int lds_byte(int r, int c) { const int st = (r >> 4) * 2 + (c >> 5), rr = r & 15, cc = c & 31, ob = rr * 64 + cc * 2; return st * 1024 + (ob ^ (((ob >> 9) & 1) << 5)); }
__host__ __device__ __forceinline__ void stage_rc(int b, int& R, int& C) { const int st = b / 1024, sb = b % 1024, swz = sb ^ (((sb >> 9) & 1) << 5); R = (st >> 1) * 16 + swz / 64; C = (st & 1) * 32 + (swz % 64) / 2; }
__host__ __device__ __forceinline__ int perm32(int rho) { const int n = rho >> 4, i = rho & 15; return 8 * (i >> 2) + 4 * n + (i & 3); }

struct Unit { int pm, pn; };
struct Gemm { const bf16_t* A; const bf16_t* Bt; int M, N, K; };

struct StaticOrder {
    int nM, nN, nwg, G, c;
    __host__ __device__ void init(int M, int N, int G_, int c_) { nM = M / BM; nN = N / BM; nwg = nM * nN; G = G_; c = c_; }
    __host__ __device__ bool next(int i, Unit& u) const {
        const long L = (long)i * G + c; if (L >= nwg) return false;
        int wgid = (int)L; { const int q = nwg / NXCD, r = nwg % NXCD, xcd = wgid % NXCD, off = wgid / NXCD; wgid = (xcd < r ? xcd * (q + 1) : r * (q + 1) + (xcd - r) * q) + off; }
        const int nig = WGM * nN, gid = wgid / nig, fm = gid * WGM, gsz = (nM - fm) < WGM ? (nM - fm) : WGM;
        u.pm = fm + ((wgid % nig) % gsz); u.pn = (wgid % nig) / gsz; return true;
    }
    __device__ __forceinline__ void a_ready(const Unit&) const {}
    __device__ __forceinline__ void done(const Unit&) const {}
};

typedef float f32x2c_t __attribute__((ext_vector_type(2))); typedef __bf16 bf16x2c_t __attribute__((ext_vector_type(2)));
__device__ __forceinline__ unsigned cvt_pk_bf16(float lo, float hi) { f32x2c_t v = {lo, hi}; bf16x2c_t b = __builtin_convertvector(v, bf16x2c_t); return __builtin_bit_cast(unsigned, b); }
typedef float f32x2 __attribute__((ext_vector_type(2)));
typedef unsigned u32x2 __attribute__((ext_vector_type(2)));
constexpr int MP = 16384;
constexpr size_t OFF_Y = 0, OFF_KP = 17039360, OFF_VP = 25427968, OFF_CP = 33816576, OFF_KS = 33818624, OFF_VS = 33949696, OFF_CS = 34080768;
__device__ __forceinline__ u32x4 pack8(f32x4 a, f32x4 b) { u32x4 w; w.x = cvt_pk_bf16(a[0], a[1]); w.y = cvt_pk_bf16(a[2], a[3]); w.z = cvt_pk_bf16(b[0], b[1]); w.w = cvt_pk_bf16(b[2], b[3]); return w; }
__device__ __forceinline__ void unpack8(u32x4 w, f32x4& a, f32x4& b) {
    a[0] = __uint_as_float(w.x << 16); a[1] = __uint_as_float(w.x & 0xffff0000u); a[2] = __uint_as_float(w.y << 16); a[3] = __uint_as_float(w.y & 0xffff0000u);
    b[0] = __uint_as_float(w.z << 16); b[1] = __uint_as_float(w.z & 0xffff0000u); b[2] = __uint_as_float(w.w << 16); b[3] = __uint_as_float(w.w & 0xffff0000u); }
__device__ __forceinline__ float sigmoidf_fast(float x) { return __builtin_amdgcn_rcpf(1.0f + __builtin_amdgcn_exp2f(-1.4426950408889634f * x)); }
__device__ __forceinline__ f32x4 sig4(f32x4 v) { f32x4 r; r[0] = sigmoidf_fast(v[0]); r[1] = sigmoidf_fast(v[1]); r[2] = sigmoidf_fast(v[2]); r[3] = sigmoidf_fast(v[3]); return r; }

struct EpiProj {
    static constexpr bool PERM = true, AFTER_DRAIN = false;
    bf16_t *CU, *BG, *Q, *KB, *VB, *SGC, *SGA; float* out; float qscale;
    __device__ __forceinline__ void operator()(const f32x4 (&acc)[2][2][4][2], const Unit& u, int wr, int wc, int fr, int fq) const {
        const int row0 = u.pm * BM + wr * 64 + fr, c8 = wc * 32 + 8 * fq, pn = u.pn;
        if (pn < 4) {
            const int j = pn * 128 + c8;
#pragma unroll
            for (int ai = 0; ai < 2; ++ai)
#pragma unroll
                for (int m = 0; m < 4; ++m) { const int row = row0 + ai * HALF + m * 16;
                    const f32x4 a0 = acc[ai][0][m][0] * acc[ai][1][m][0], a1 = acc[ai][0][m][1] * acc[ai][1][m][1];
                    *(u32x4*)(CU + (size_t)row * 512 + j) = pack8(a0, a1);
                    float* cs = nullptr;
                    if (row < MP) { const int t = row & 8191; if (t >= 8190) cs = out + OFF_CP + (size_t)(((row >> 13) * 2 + (t - 8190)) * 512 + j); }
                    else { const int r = row - MP, i = r & 7; if (i >= 6) cs = out + OFF_CS + (size_t)(((r >> 3) * 2 + (i - 6)) * 512 + j); }
                    if (cs) { *(f32x4*)cs = a0; *(f32x4*)(cs + 4) = a1; } }
        } else if (pn < 12) {
            const int kind = (pn - 4) >> 1;
            bf16_t* dst = BG + (size_t)kind * (size_t)(18u << 19); const float sc = kind == 1 ? qscale : 1.0f;
            const int colb = ((pn - 4) & 1) * 256 + c8;
#pragma unroll
            for (int ai = 0; ai < 2; ++ai)
#pragma unroll
                for (int m = 0; m < 4; ++m) { const int row = row0 + ai * HALF + m * 16;
#pragma unroll
                    for (int bj = 0; bj < 2; ++bj) { const int col = colb + bj * HALF; const f32x4 v0 = acc[ai][bj][m][0] * sc, v1 = acc[ai][bj][m][1] * sc;
                        *(u32x4*)(dst + (size_t)row * 512 + col) = pack8(v0, v1);
                        if (kind >= 2) { float* o = out + (kind == 2 ? (row < MP ? OFF_KP : OFF_KS) : (row < MP ? OFF_VP : OFF_VS)) + (size_t)(row < MP ? row : row - MP) * 512 + col;
                            *(f32x4*)o = v0; *(f32x4*)(o + 4) = v1; } } }
        } else {
            bf16_t* dst = pn < 16 ? SGC : SGA; const int colb = ((pn - 12) & 3) * 256 + c8;
#pragma unroll
            for (int ai = 0; ai < 2; ++ai)
#pragma unroll
                for (int m = 0; m < 4; ++m) { const int row = row0 + ai * HALF + m * 16;
#pragma unroll
                    for (int bj = 0; bj < 2; ++bj) { const int col = colb + bj * HALF;
                        *(u32x4*)(dst + (size_t)row * 1024 + col) = pack8(sig4(acc[ai][bj][m][0]), sig4(acc[ai][bj][m][1])); } }
        }
    }
};
template <int MODE> struct EpiBf {
    static constexpr bool PERM = true, AFTER_DRAIN = false;
    bf16_t* O; int ldc; const bf16_t* G1; const bf16_t* ADD;
    __device__ __forceinline__ void operator()(const f32x4 (&acc)[2][2][4][2], const Unit& u, int wr, int wc, int fr, int fq) const {
        const int row0 = u.pm * BM + wr * 64 + fr, col0 = u.pn * BM + wc * 32 + 8 * fq;
#pragma unroll
        for (int ai = 0; ai < 2; ++ai)
#pragma unroll
            for (int m = 0; m < 4; ++m) { const size_t ro = (size_t)(row0 + ai * HALF + m * 16) * ldc + col0;
#pragma unroll
                for (int bj = 0; bj < 2; ++bj) { f32x4 v0 = acc[ai][bj][m][0], v1 = acc[ai][bj][m][1];
                    if (MODE == 0 || MODE == 1) { f32x4 g0, g1; unpack8(*(const u32x4*)(G1 + ro + bj * HALF), g0, g1); v0 = v0 * g0; v1 = v1 * g1; }
                    if (MODE == 1) { f32x4 t0, t1; unpack8(*(const u32x4*)(ADD + ro + bj * HALF), t0, t1); v0 = v0 + t0; v1 = v1 + t1; }
                    if (MODE == 2) { v0 = __builtin_elementwise_max(v0, (f32x4){0.f, 0.f, 0.f, 0.f}); v1 = __builtin_elementwise_max(v1, (f32x4){0.f, 0.f, 0.f, 0.f}); v0 = v0 * v0; v1 = v1 * v1; }
                    *(u32x4*)(O + ro + bj * HALF) = pack8(v0, v1); } }
    }
};
struct EpiResF32 {
    static constexpr bool PERM = false, AFTER_DRAIN = false;
    const float* base0; const float* base1; float* out;
    __device__ __forceinline__ void operator()(const f32x4 (&acc)[2][2][4][2], const Unit& u, int wr, int wc, int fr, int fq) const {
        const int row0 = u.pm * BM + wr * 64 + fr, col0 = u.pn * BM + wc * 32 + 4 * fq;
#pragma unroll
        for (int ai = 0; ai < 2; ++ai)
#pragma unroll
            for (int m = 0; m < 4; ++m) { const int row = row0 + ai * HALF + m * 16; const float* bp = (row < MP ? base0 + (size_t)row * 1024 : base1 + (size_t)(row - MP) * 1024) + col0; float* op = out + (size_t)row * 1024 + col0;
#pragma unroll
                for (int bj = 0; bj < 2; ++bj)
#pragma unroll
                    for (int n = 0; n < 2; ++n) *(f32x4*)(op + bj * HALF + n * 16) = *(const f32x4*)(bp + bj * HALF + n * 16) + acc[ai][bj][m][n]; }
    }
};
template <class Epi, class Sched, bool ALIGN_EPI = false, bool SP2 = false>
__device__ __forceinline__ void gemm_phase(PG8_LAS unsigned char* lds, const Gemm g, const Sched& S, const Epi& E) {
    const int tid = threadIdx.x, wid = __builtin_amdgcn_readfirstlane(tid >> 6), lane = tid & 63, wr = wid >> 2, wc = wid & 3, fr = lane & 15, fq = lane >> 4;
    const int K = g.K, nt = K / BK;
    unsigned voffA[2], voffB[2];
#pragma unroll
    for (int i = 0; i < 2; ++i) { int R, C; stage_rc(tid * 16 + i * 8192, R, C); const int Rb = Epi::PERM ? ((R & ~31) + perm32(R & 31)) : R;
        voffA[i] = (unsigned)(R * K + C) * 2u; voffB[i] = (unsigned)(Rb * K + C) * 2u; }
    const size_t kstep = (size_t)(BK * 2);
    const size_t hstep = (size_t)HALF * K * 2;
    const size_t tstep = 2 * hstep;
    const unsigned ldsw = (unsigned)wid * 1024u;
    const int aoff = lds_byte(wr * 64 + fr, fq * 8), boff = lds_byte(wc * 32 + fr, fq * 8);
#define PG8_SA(b, h) (((b) * 2 + (h)) * HTB)
#define PG8_SB(b, h) ((4 + (b) * 2 + (h)) * HTB)
#define PG8_STAGE(bufoff, gbase, voff) do { _Pragma("unroll") for (int _i = 0; _i < 2; ++_i) \
        __builtin_amdgcn_global_load_lds((const unsigned*)((const char*)(gbase) + (voff)[_i]), (PG8_LAS unsigned*)(lds + (bufoff) + ldsw + _i * 8192), 16, 0, 0); } while (0)
#define PG8_LDA(dst, b, h) do { _Pragma("unroll") for (int m = 0; m < 4; ++m) _Pragma("unroll") for (int k = 0; k < 2; ++k) dst[m][k] = *(const PG8_LAS bf16x8*)(lds + PG8_SA(b, h) + aoff + m * 2048 + k * 1024); } while (0)
#define PG8_LDB(dst, b, h) do { _Pragma("unroll") for (int n = 0; n < 2; ++n) _Pragma("unroll") for (int k = 0; k < 2; ++k) dst[n][k] = *(const PG8_LAS bf16x8*)(lds + PG8_SB(b, h) + boff + n * 2048 + k * 1024); } while (0)
#define PG8_MMA(ai, bj, At, Bt) do { __builtin_amdgcn_s_setprio(1); _Pragma("unroll") for (int m = 0; m < 4; ++m) _Pragma("unroll") for (int n = 0; n < 2; ++n) _Pragma("unroll") for (int k = 0; k < 2; ++k) \
        acc[ai][bj][m][n] = __builtin_amdgcn_mfma_f32_16x16x32_bf16(Bt[n][k], At[m][k], acc[ai][bj][m][n], 0, 0, 0); __builtin_amdgcn_s_setprio(0); } while (0)
#define PG8_WAIT_V(n) asm volatile("s_waitcnt vmcnt(" #n ")" ::: "memory")
#define PG8_WAIT_L(n) asm volatile("s_waitcnt lgkmcnt(" #n ")" ::: "memory")
#define PG8_BAR __builtin_amdgcn_s_barrier()
#define PG8_SCHED __builtin_amdgcn_sched_barrier(0)
    Unit cur, nxt; int ui = 0;
    if (!S.next(0, cur)) return;
    f32x4 acc[2][2][4][2];
#pragma unroll
    for (int a = 0; a < 2; ++a)
#pragma unroll
        for (int b = 0; b < 2; ++b)
#pragma unroll
            for (int m = 0; m < 4; ++m)
#pragma unroll
                for (int n = 0; n < 2; ++n) acc[a][b][m][n] = (f32x4){0.f, 0.f, 0.f, 0.f};
    bf16x8 At[4][2], B0[2][2], B1[2][2];
    const char* cA = (const char*)g.A + (size_t)cur.pm * tstep; const char* cB = (const char*)g.Bt + (size_t)cur.pn * tstep;
    S.a_ready(cur);
    if constexpr (SP2) {
        PG8_STAGE(PG8_SB(0, 0), cB, voffB); PG8_STAGE(PG8_SB(0, 1), cB + hstep, voffB); PG8_STAGE(PG8_SA(0, 0), cA, voffA); PG8_STAGE(PG8_SA(0, 1), cA + hstep, voffA);
        if (wr == 1) PG8_BAR;
        PG8_WAIT_V(2); PG8_BAR;
        PG8_STAGE(PG8_SB(1, 0), cB + kstep, voffB); PG8_STAGE(PG8_SA(1, 0), cA + kstep, voffA); PG8_STAGE(PG8_SB(1, 1), cB + hstep + kstep, voffB);
        PG8_WAIT_V(6); PG8_BAR;
    } else {
        PG8_STAGE(PG8_SB(0, 0), cB, voffB); PG8_STAGE(PG8_SA(0, 0), cA, voffA); PG8_STAGE(PG8_SB(0, 1), cB + hstep, voffB); PG8_STAGE(PG8_SA(0, 1), cA + hstep, voffA);
        if (wr == 1) PG8_BAR;
        PG8_WAIT_V(4); PG8_BAR;
        PG8_STAGE(PG8_SB(1, 0), cB + kstep, voffB); PG8_STAGE(PG8_SA(1, 0), cA + kstep, voffA); PG8_STAGE(PG8_SB(1, 1), cB + hstep + kstep, voffB);
        PG8_WAIT_V(6); PG8_BAR;
    }
    for (;;) {
        const bool has_next = S.next(ui + 1, nxt);
        const char* nA = has_next ? (const char*)g.A + (size_t)nxt.pm * tstep : cA; const char* nB = has_next ? (const char*)g.Bt + (size_t)nxt.pn * tstep : cB;
        for (int t = 0; t < nt; t += 2) {
            const bool last = (t == nt - 2);
            const char* a1 = cA + (size_t)(t + 1) * kstep;
            const char* a2 = last ? nA : cA + (size_t)(t + 2) * kstep; const char* b2 = last ? nB : cB + (size_t)(t + 2) * kstep;
            const char* a3 = a2 + kstep; const char* b3 = b2 + kstep;
            if (last && has_next) S.a_ready(nxt);
            if constexpr (SP2) {
            PG8_LDB(B0, 0, 0); PG8_LDB(B1, 0, 1); PG8_SCHED; PG8_LDA(At, 0, 0); PG8_STAGE(PG8_SA(1, 1), a1 + hstep, voffA);
            PG8_WAIT_V(8); PG8_WAIT_L(0); PG8_BAR; PG8_MMA(0, 0, At, B0); PG8_MMA(0, 1, At, B1); PG8_BAR; PG8_SCHED;
            PG8_LDA(At, 0, 1); PG8_STAGE(PG8_SB(0, 0), b2, voffB); PG8_STAGE(PG8_SB(0, 1), b2 + hstep, voffB); PG8_STAGE(PG8_SA(0, 0), a2, voffA);
            PG8_WAIT_V(8); PG8_WAIT_L(0); PG8_BAR; PG8_MMA(1, 0, At, B0); PG8_MMA(1, 1, At, B1); PG8_BAR; PG8_SCHED;
            PG8_LDB(B0, 1, 0); PG8_LDB(B1, 1, 1); PG8_SCHED; PG8_LDA(At, 1, 0); PG8_STAGE(PG8_SA(0, 1), a2 + hstep, voffA);
            PG8_WAIT_V(8); PG8_WAIT_L(0); PG8_BAR; PG8_MMA(0, 0, At, B0); PG8_MMA(0, 1, At, B1); PG8_BAR; PG8_SCHED;
            PG8_LDA(At, 1, 1); PG8_STAGE(PG8_SB(1, 0), b3, voffB); PG8_STAGE(PG8_SB(1, 1), b3 + hstep, voffB); PG8_STAGE(PG8_SA(1, 0), a3, voffA);
            PG8_WAIT_V(8); PG8_WAIT_L(0); PG8_BAR; PG8_MMA(1, 0, At, B0); PG8_MMA(1, 1, At, B1); PG8_BAR; PG8_SCHED;
            } else {
            PG8_LDB(B0, 0, 0); PG8_SCHED; PG8_LDA(At, 0, 0); PG8_STAGE(PG8_SA(1, 1), a1 + hstep, voffA);
            PG8_WAIT_L(8); PG8_BAR; PG8_WAIT_L(0); PG8_MMA(0, 0, At, B0); PG8_BAR; PG8_SCHED;
            PG8_LDB(B1, 0, 1); PG8_STAGE(PG8_SB(0, 0), b2, voffB);
            PG8_BAR; PG8_WAIT_L(0); PG8_MMA(0, 1, At, B1); PG8_BAR;
            PG8_LDA(At, 0, 1); PG8_STAGE(PG8_SA(0, 0), a2, voffA);
            PG8_BAR; PG8_WAIT_L(0); PG8_MMA(1, 0, At, B0); PG8_BAR; PG8_SCHED;
            PG8_STAGE(PG8_SB(0, 1), b2 + hstep, voffB);
            PG8_WAIT_V(6); PG8_BAR; PG8_MMA(1, 1, At, B1); PG8_BAR;
            PG8_LDB(B0, 1, 0); PG8_SCHED; PG8_LDA(At, 1, 0); PG8_STAGE(PG8_SA(0, 1), a2 + hstep, voffA);
            PG8_WAIT_L(8); PG8_BAR; PG8_WAIT_L(0); PG8_MMA(0, 0, At, B0); PG8_BAR; PG8_SCHED;
            PG8_LDB(B1, 1, 1); PG8_STAGE(PG8_SB(1, 0), b3, voffB);
            PG8_BAR; PG8_WAIT_L(0); PG8_MMA(0, 1, At, B1); PG8_BAR;
            PG8_LDA(At, 1, 1); PG8_STAGE(PG8_SA(1, 0), a3, voffA);
            PG8_BAR; PG8_WAIT_L(0); PG8_MMA(1, 0, At, B0); PG8_BAR; PG8_SCHED;
            PG8_STAGE(PG8_SB(1, 1), b3 + hstep, voffB);
            PG8_WAIT_V(6); PG8_BAR; PG8_MMA(1, 1, At, B1); PG8_BAR;
            }
        }
        if constexpr (ALIGN_EPI) { if (wr == 0) PG8_BAR; }
        if constexpr (!Epi::AFTER_DRAIN) { E(acc, cur, wr, wc, fr, fq); S.done(cur); }
        if (!has_next) break;
#pragma unroll
        for (int a = 0; a < 2; ++a)
#pragma unroll
            for (int b = 0; b < 2; ++b)
#pragma unroll
                for (int m = 0; m < 4; ++m)
#pragma unroll
                    for (int n = 0; n < 2; ++n) acc[a][b][m][n] = (f32x4){0.f, 0.f, 0.f, 0.f};
        cur = nxt; cA = nA; cB = nB; ++ui;
        if constexpr (ALIGN_EPI) { if (wr == 1) PG8_BAR; }
    }
    PG8_WAIT_V(0);
    if constexpr (!ALIGN_EPI) { if (wr == 0) PG8_BAR; }
    PG8_BAR;
    if constexpr (Epi::AFTER_DRAIN) { E.fused(acc, cur, wr, wc, fr, fq, lds, wid, lane); S.done(cur); }
#undef PG8_SA
#undef PG8_SB
#undef PG8_STAGE
#undef PG8_LDA
#undef PG8_LDB
#undef PG8_MMA
#undef PG8_WAIT_V
#undef PG8_WAIT_L
#undef PG8_BAR
#undef PG8_SCHED
}
}
#define GAS __attribute__((address_space(1)))
#define LAS __attribute__((address_space(3)))
typedef unsigned short bf16;
typedef unsigned v4u __attribute__((ext_vector_type(4)));
typedef float f32x4 __attribute__((ext_vector_type(4)));
typedef short bf16x8 __attribute__((ext_vector_type(8)));
typedef GAS unsigned gu32;
typedef GAS unsigned long long gu64;
#define RLX_AGENT __ATOMIC_RELAXED, __HIP_MEMORY_SCOPE_AGENT
#define LDS_WAIT() asm volatile("s_waitcnt lgkmcnt(0)" ::: "memory")
#define VM_WAIT() asm volatile("s_waitcnt vmcnt(0)" ::: "memory")
__device__ __forceinline__ unsigned long long rt() { return __builtin_amdgcn_s_memrealtime(); }
__device__ __forceinline__ unsigned f2bf(float f) { unsigned u = __builtin_bit_cast(unsigned, f); return (u + 0x7fffu + ((u >> 16) & 1u)) >> 16; }
__device__ __forceinline__ unsigned pk2(float lo, float hi) { return f2bf(lo) | (f2bf(hi) << 16); }
#define XB_TMO      128
#define XB_XCNT(j)  (256  + 64 * (j))
#define XB_XSUB(j)  (1280 + 64 * (j))
#define XB_XGEN(j)  (2304 + 64 * (j))
#define XB_TOP      3328
#define XB_TOPGEN   3392
#define XCD_BAR_WORDS 3456
#define XB_SPIN_CAP (1u << 24)

__device__ __forceinline__ unsigned xb_ld(unsigned* p)              { return __hip_atomic_load(p, __ATOMIC_RELAXED, __HIP_MEMORY_SCOPE_AGENT); }
__device__ __forceinline__ unsigned xb_add(unsigned* p, unsigned v) { return __hip_atomic_fetch_add(p, v, __ATOMIC_RELAXED, __HIP_MEMORY_SCOPE_AGENT); }
__device__ __forceinline__ unsigned xb_xcc_id() { return (unsigned)__builtin_amdgcn_s_getreg((3 << 11) | 20) & 0xFu; }
#define XB_SPIN(cond, bar) do { unsigned _sp = 0; while (cond) { __builtin_amdgcn_s_sleep(1); \
    if ((++_sp & 255u) == 0u) { if (xb_ld(&(bar)[XB_TMO])) break; if (_sp > XB_SPIN_CAP) { atomicAdd(&(bar)[XB_TMO], 1u); break; } } } } while (0)

struct XcdBarrier {
    unsigned* bar; unsigned x;
    volatile LAS unsigned* st;
};

__device__ __forceinline__ XcdBarrier xcd_barrier_post(unsigned* bar, volatile LAS unsigned* st) {
    XcdBarrier b; b.bar = bar; b.x = xb_xcc_id(); b.st = st;
    if (threadIdx.x == 0) (void)xb_add(&bar[XB_XCNT(b.x)], 1u);
    return b;
}
__device__ __forceinline__ void xcd_barrier_complete(unsigned* bar, unsigned x, unsigned& nloc, unsigned& nx) {
    const unsigned G = gridDim.x * gridDim.y * gridDim.z;
    unsigned sum, cnt, mine, sp = 0u;
    for (;;) {
        sum = 0u; cnt = 0u; mine = 0u;
#pragma unroll
        for (unsigned j = 0; j < 16; ++j) { const unsigned c = xb_ld(&bar[XB_XCNT(j)]); sum += c; cnt += (c > 0u) ? 1u : 0u; mine = (j == x) ? c : mine; }
        if (sum == G) break;
        __builtin_amdgcn_s_sleep(1);
        if ((++sp & 255u) == 0u) { if (xb_ld(&bar[XB_TMO])) break; if (sp > XB_SPIN_CAP) { atomicAdd(&bar[XB_TMO], 1u); break; } }
    }
    nloc = mine > 0u ? mine : 1u; nx = cnt > 0u ? cnt : 1u;
}

__device__ __forceinline__ void xcd_barrier(const XcdBarrier& b) {
    asm volatile("s_waitcnt vmcnt(0)" ::: "memory");
    __syncthreads();
    if (threadIdx.x == 0) {
        unsigned* bar = b.bar;
        __builtin_amdgcn_s_waitcnt(0);
        unsigned nloc = b.st[0], nx = b.st[1];
        if (nloc == 0u) { xcd_barrier_complete(bar, b.x, nloc, nx); b.st[0] = nloc; b.st[1] = nx; }
        const unsigned old = xb_add(&bar[XB_XSUB(b.x)], 1u);
        const unsigned gen = old / nloc;
        if (old + 1u == (gen + 1u) * nloc) {
            __builtin_amdgcn_fence(__ATOMIC_RELEASE, "agent");
            asm volatile("s_waitcnt vmcnt(0)" ::: "memory");
            const unsigned og = xb_add(&bar[XB_TOP], 1u);
            const unsigned tg = og / nx;
            if (og + 1u == (tg + 1u) * nx) xb_add(&bar[XB_TOPGEN], 1u);
            else XB_SPIN(xb_ld(&bar[XB_TOPGEN]) == tg, bar);
            __builtin_amdgcn_fence(__ATOMIC_ACQUIRE, "agent");
            xb_add(&bar[XB_XGEN(b.x)], 1u);
            asm volatile("s_waitcnt vmcnt(0)" ::: "memory");
        } else {
            XB_SPIN(xb_ld(&bar[XB_XGEN(b.x)]) == gen, bar);
            __builtin_amdgcn_fence(__ATOMIC_ACQUIRE, "agent");
            asm volatile("s_waitcnt vmcnt(0)" ::: "memory");
        }
    }
    __syncthreads();
}
namespace sba {
using bf16x8 = __attribute__((ext_vector_type(8))) short;
using s16x4 = __attribute__((ext_vector_type(4))) short;
using f32x16 = __attribute__((ext_vector_type(16))) float;
using u32x4 = __attribute__((ext_vector_type(4))) unsigned;
typedef unsigned short bf16;
constexpr int SEQ = 8192, D = 64, PITCH = 512, NW = 8, QBLK = 32, QB = 256, KVBLK = 64;
constexpr int NSLOT = 4, SLOTB = 8192;
constexpr int LDS_K = 0, LDS_V = NSLOT * SLOTB, LDS_OST = 2 * NSLOT * SLOTB, LDS_BYTES = LDS_OST + NW * 4096;
__device__ __forceinline__ int crow(int r, int hi) { return (r & 3) + 8 * (r >> 2) + 4 * hi; }
__device__ __forceinline__ void glds16(const void* gsrc, unsigned lds_dst) { unsigned keep;
    asm volatile("s_mov_b32 %0, m0\n\ts_mov_b32 m0, %2\n\ts_nop 0\n\tglobal_load_lds_dwordx4 %1, off\n\ts_mov_b32 m0, %0" : "=&s"(keep) : "v"(gsrc), "s"(lds_dst) : "memory"); }
typedef float f32x2_t __attribute__((ext_vector_type(2))); typedef __bf16 bf16x2_t __attribute__((ext_vector_type(2)));
__device__ __forceinline__ unsigned cvtpk(float lo, float hi) { f32x2_t v = {lo, hi}; bf16x2_t b = __builtin_convertvector(v, bf16x2_t); return __builtin_bit_cast(unsigned, b); }
typedef __attribute__((address_space(3))) const char* lds_cptr;
typedef short v4i16_t __attribute__((ext_vector_type(4)));
__device__ __forceinline__ s16x4 vtr(lds_cptr p) { return __builtin_bit_cast(s16x4, __builtin_amdgcn_ds_read_tr16_b64_v4i16((__attribute__((address_space(3))) v4i16_t*)p)); }
#define SBA_WAIT_BAR(N) asm volatile("s_waitcnt vmcnt(" #N ") lgkmcnt(0)\n\ts_barrier" ::: "memory")

__device__ __forceinline__ void qkt(f32x16& p0, f32x16& p1, lds_cptr kb, const bf16x8* qr) {
    const f32x16 z = {};
#pragma unroll
    for (int d0 = 0; d0 < 4; ++d0) {
        const bf16x8 b0 = *(const __attribute__((address_space(3))) bf16x8*)(kb + d0 * 2048);
        const bf16x8 b1 = *(const __attribute__((address_space(3))) bf16x8*)(kb + d0 * 2048 + 512);
        if (d0 == 0) { p0 = __builtin_amdgcn_mfma_f32_32x32x16_bf16(b0, qr[0], z, 0, 0, 0); p1 = __builtin_amdgcn_mfma_f32_32x32x16_bf16(b1, qr[0], z, 0, 0, 0); }
        else { p0 = __builtin_amdgcn_mfma_f32_32x32x16_bf16(b0, qr[d0], p0, 0, 0, 0); p1 = __builtin_amdgcn_mfma_f32_32x32x16_bf16(b1, qr[d0], p1, 0, 0, 0); } }
}
__device__ __forceinline__ void qkt1(f32x16& p, lds_cptr kb, const bf16x8* qr) {
    const f32x16 z = {};
#pragma unroll
    for (int d0 = 0; d0 < 4; ++d0) { const bf16x8 kf = *(const __attribute__((address_space(3))) bf16x8*)(kb + d0 * 2048);
        p = __builtin_amdgcn_mfma_f32_32x32x16_bf16(kf, qr[d0], d0 == 0 ? z : p, 0, 0, 0); }
}
__device__ __forceinline__ void pv(f32x16* o, lds_cptr vp, bf16x8 pa0, bf16x8 pa1, bf16x8 pa2, bf16x8 pa3) {
#pragma unroll
    for (int d0 = 0; d0 < 2; ++d0) { s16x4 lo[4], hi[4];
#pragma unroll
        for (int ks = 0; ks < 4; ++ks) { lo[ks] = vtr(vp + d0 * 4096 + ks * 1024); hi[ks] = vtr(vp + d0 * 4096 + ks * 1024 + 512); }
#define SBA_PK(k) (bf16x8){lo[k][0], lo[k][1], lo[k][2], lo[k][3], hi[k][0], hi[k][1], hi[k][2], hi[k][3]}
        o[d0] = __builtin_amdgcn_mfma_f32_32x32x16_bf16(pa0, SBA_PK(0), o[d0], 0, 0, 0);
        o[d0] = __builtin_amdgcn_mfma_f32_32x32x16_bf16(pa1, SBA_PK(1), o[d0], 0, 0, 0);
        o[d0] = __builtin_amdgcn_mfma_f32_32x32x16_bf16(pa2, SBA_PK(2), o[d0], 0, 0, 0);
        o[d0] = __builtin_amdgcn_mfma_f32_32x32x16_bf16(pa3, SBA_PK(3), o[d0], 0, 0, 0);
#undef SBA_PK
    }
}
__device__ __forceinline__ void pv2(f32x16* o, lds_cptr vp, bf16x8 pa0, bf16x8 pa1) {
#pragma unroll
    for (int d0 = 0; d0 < 2; ++d0) { s16x4 lo[2], hi[2];
#pragma unroll
        for (int ks = 0; ks < 2; ++ks) { lo[ks] = vtr(vp + d0 * 4096 + ks * 1024); hi[ks] = vtr(vp + d0 * 4096 + ks * 1024 + 512); }
        o[d0] = __builtin_amdgcn_mfma_f32_32x32x16_bf16(pa0, (bf16x8){lo[0][0], lo[0][1], lo[0][2], lo[0][3], hi[0][0], hi[0][1], hi[0][2], hi[0][3]}, o[d0], 0, 0, 0);
        o[d0] = __builtin_amdgcn_mfma_f32_32x32x16_bf16(pa1, (bf16x8){lo[1][0], lo[1][1], lo[1][2], lo[1][3], hi[1][0], hi[1][1], hi[1][2], hi[1][3]}, o[d0], 0, 0, 0); }
}
__device__ __forceinline__ float sba_mul(float a, float b) { float m = a * b; asm("" : "+v"(m)); return m; }
#define SBA_MUL(a, b) sba_mul((a), (b))
__device__ __forceinline__ float sb_block(const f32x16& p, float Din, bool hiLane, float Eb, u32x4& wA, u32x4& wB) {
    float x[16], a[16];
#pragma unroll
    for (int r = 0; r < 16; ++r) { x[r] = __builtin_amdgcn_exp2f(p[r]); a[r] = __builtin_fmaf(x[r], Eb, 1.0f); asm("" : "+v"(a[r])); }
    float own[4];
#pragma unroll
    for (int j = 0; j < 4; ++j) own[j] = SBA_MUL(SBA_MUL(a[4 * j], a[4 * j + 1]), SBA_MUL(a[4 * j + 2], a[4 * j + 3]));
    const float g16 = SBA_MUL(SBA_MUL(own[0], own[1]), SBA_MUL(own[2], own[3]));
    const auto rr = __builtin_amdgcn_permlane32_swap(__float_as_uint(g16), __float_as_uint(g16), false, false);
    const float vlo = __uint_as_float(rr[0]), vhi = __uint_as_float(rr[1]);
    const float dh = SBA_MUL(Din, vhi), Dout = SBA_MUL(dh, vlo);
    float P = hiLane ? Din : dh;
    float w[16];
#pragma unroll
    for (int j = 3; j >= 0; --j) { P = SBA_MUL(P, own[j]);
        const float R0 = SBA_MUL(__builtin_amdgcn_rcpf(P), Eb);
        w[4 * j] = SBA_MUL(x[4 * j], R0); float t = SBA_MUL(R0, a[4 * j]); w[4 * j + 1] = SBA_MUL(x[4 * j + 1], t); t = SBA_MUL(t, a[4 * j + 1]); w[4 * j + 2] = SBA_MUL(x[4 * j + 2], t);
        t = SBA_MUL(t, a[4 * j + 2]); w[4 * j + 3] = SBA_MUL(x[4 * j + 3], t); }
    wA = (u32x4){cvtpk(w[0], w[1]), cvtpk(w[2], w[3]), cvtpk(w[4], w[5]), cvtpk(w[6], w[7])};
    wB = (u32x4){cvtpk(w[8], w[9]), cvtpk(w[10], w[11]), cvtpk(w[12], w[13]), cvtpk(w[14], w[15])};
    return Dout;
}
__device__ __forceinline__ int PI(int rho) { return 16 * ((rho >> 2) & 1) + 4 * (rho >> 3) + (rho & 3); }
__device__ __forceinline__ void unit(int b, int h, int qb, const bf16* Q, const bf16* __restrict__ K, const bf16* __restrict__ V, bf16* O, float biasl, char* shm) {
    int tid = threadIdx.x; asm volatile("" : "+v"(tid));
    const int lane = tid & 63, r32 = lane & 31, hi = lane >> 5; const int wid = __builtin_amdgcn_readfirstlane(tid >> 6);
    const long rowbase = (long)b * SEQ; const int q0 = qb * QB, NT = (q0 + QB) / KVBLK;
    const bf16* Qw = Q + (rowbase + q0 + wid * QBLK) * PITCH + h * D;
    const bf16* Kh = K + rowbase * PITCH + h * D; const bf16* Vh = V + rowbase * PITCH + h * D;
    const unsigned lds0 = (unsigned)(uintptr_t)shm;
    const int vrho = 16 * (wid & 3) + (lane >> 2);
    const bf16* ksrc = Kh + (long)((lane & 32) + PI(lane & 31)) * PITCH + wid * 8;
    const bf16* vsrc = Vh + (long)((vrho & 32) + PI(vrho & 31)) * PITCH + (wid >> 2) * 32 + (lane & 3) * 8;
    const unsigned kdst = lds0 + LDS_K + wid * 1024, vdst = lds0 + LDS_V + wid * 1024;
#define SBA_DMA(t, slot) do { glds16(ksrc + (long)(t) * KVBLK * PITCH, (unsigned)__builtin_amdgcn_readfirstlane(kdst + (slot))); glds16(vsrc + (long)(t) * KVBLK * PITCH, (unsigned)__builtin_amdgcn_readfirstlane(vdst + (slot))); } while (0)
    const lds_cptr shm3 = (lds_cptr)shm; const lds_cptr kp0 = shm3 + LDS_K + hi * 1024 + r32 * 16;
    const lds_cptr vp0 = shm3 + LDS_V + ((lane >> 4) & 1) * 32 + (lane & 3) * 8 + (4 * hi + ((lane & 15) >> 2)) * 64;
    bf16x8 qr[4];
#pragma unroll
    for (int d0 = 0; d0 < 4; ++d0) qr[d0] = *reinterpret_cast<const bf16x8*>(&Qw[(long)r32 * PITCH + d0 * 16 + hi * 8]);
    SBA_DMA(NT - 1, 0); SBA_DMA(NT - 2, SLOTB); SBA_DMA(NT - 3, 2 * SLOTB);
    f32x16 o[2]; o[0] = f32x16{}; o[1] = f32x16{};
    const float Eb = __builtin_amdgcn_exp2f(biasl);
    float Dc = 1.0f;
    const int qrel = wid * QBLK + r32;
    const bool hiL = hi != 0;
    f32x16 pX, pY;
    SBA_WAIT_BAR(4);
    qkt1(pX, kp0 + 512, qr);
    int slot = 0;
#define SBA_NEXT(sl) ((sl) == (NSLOT - 1) * SLOTB ? 0 : (sl) + SLOTB)
#define SBA_MASK1(P, kbase) do { const int kb_ = (kbase) + 16 * hi; _Pragma("unroll") for (int r = 0; r < 16; ++r) { if (kb_ + r >= qrel) P[r] = -INFINITY; } } while (0)
#define SBA_STEP(i, BAND) do { \
        if ((i) + 2 < NT) SBA_WAIT_BAR(2); else SBA_WAIT_BAR(0); \
        const int sl1_ = SBA_NEXT(slot); \
        if ((i) + 3 < NT) { const int sl3_ = slot == 0 ? (NSLOT - 1) * SLOTB : slot - SLOTB; SBA_DMA(NT - 4 - (i), sl3_); } \
        u32x4 wa_, wb_; \
        qkt1(pY, kp0 + slot, qr); \
        if (BAND) SBA_MASK1(pX, 64 * (3 - (i)) + 32); \
        const float Dm_ = sb_block(pX, Dc, hiL, Eb, wa_, wb_); \
        pv2(o, vp0 + slot + 2048, __builtin_bit_cast(bf16x8, wa_), __builtin_bit_cast(bf16x8, wb_)); \
        if ((i) + 1 < NT) qkt1(pX, kp0 + sl1_ + 512, qr); \
        if (BAND) SBA_MASK1(pY, 64 * (3 - (i))); \
        Dc = sb_block(pY, Dm_, hiL, Eb, wa_, wb_); \
        pv2(o, vp0 + slot, __builtin_bit_cast(bf16x8, wa_), __builtin_bit_cast(bf16x8, wb_)); \
        slot = sl1_; } while (0)
    SBA_STEP(0, true); SBA_STEP(1, true); SBA_STEP(2, true); SBA_STEP(3, true);
    for (int i = 4; i < NT; ++i) SBA_STEP(i, false);
    bf16* Ow = O + (rowbase + q0 + wid * QBLK) * PITCH + h * D;
    { bf16* stg = (bf16*)(shm + LDS_OST) + wid * 2048;
#pragma unroll
      for (int r = 0; r < 16; ++r) { const int orow = crow(r, hi);
#pragma unroll
          for (int d0 = 0; d0 < 2; ++d0) stg[orow * 64 + d0 * 32 + r32] = (bf16)(cvtpk(o[d0][r], 0.f) & 0xffffu); }
      asm volatile("s_waitcnt lgkmcnt(0)" ::: "memory");
#pragma unroll
      for (int i = 0; i < 4; ++i) { const int row = i * 8 + (lane >> 3), ch = lane & 7; const u32x4 v = *(const u32x4*)(stg + row * 64 + ch * 8); *(u32x4*)(Ow + (long)row * PITCH + ch * 8) = v; } }
    asm volatile("s_waitcnt lgkmcnt(0)\n\ts_barrier" ::: "memory");
#undef SBA_DMA
#undef SBA_STEP
#undef SBA_MASK1
#undef SBA_NEXT
}
#undef SBA_WAIT_BAR

constexpr int SMP_LDS_PER_WAVE = 8192;
typedef float f32x4s __attribute__((ext_vector_type(4)));
typedef unsigned u32x2s __attribute__((ext_vector_type(2)));
__device__ __forceinline__ void sample_group(int b, int g, const bf16* Q, const float* __restrict__ ck, const float* __restrict__ cv, const int* __restrict__ pt,
                                             float biasl, float* PT, float* PO, char* shm, int q_row0) {
    int tid = threadIdx.x; asm volatile("" : "+v"(tid));
    const int lane = tid & 63, r32 = lane & 31, hi = lane >> 5; const int h = __builtin_amdgcn_readfirstlane(tid >> 6);
    typedef __attribute__((address_space(3))) char* lds_ptr;
    const lds_ptr kimg = (lds_ptr)shm + h * SMP_LDS_PER_WAVE, vimg = kimg + 4096;
    const lds_cptr kp0 = (lds_cptr)kimg + hi * 512 + r32 * 16;
    const lds_cptr vp0 = (lds_cptr)vimg + ((lane >> 4) & 1) * 32 + (lane & 3) * 8 + (4 * hi + ((lane & 15) >> 2)) * 64;
    const int lrow = lane >> 4, lc = lane & 15;
    const int kwoff = (lc >> 1) * 512 + (lc & 1) * 8, vwoff = (lc >> 3) * 2048 + (lc & 7) * 8;
    bf16x8 qr[4];
#pragma unroll
    for (int d0 = 0; d0 < 4; ++d0) { qr[d0] = bf16x8{}; if (r32 < 8) qr[d0] = *reinterpret_cast<const bf16x8*>(&Q[(long)(q_row0 + b * 8 + r32) * PITCH + h * D + d0 * 16 + hi * 8]); }
    f32x16 o[2]; o[0] = f32x16{}; o[1] = f32x16{};
    const float Eb = __builtin_amdgcn_exp2f(biasl); const f32x16 zc = {};
    float Dc = 1.0f;
    f32x4s kreg[8], vreg[8];
    const int loff = lrow * 512 + lc * 4;
    auto issue = [&](int ht) { const int page = __builtin_amdgcn_readfirstlane(pt[b * 64 + g * 8 + 7 - (ht >> 2)]); const int r0 = (3 - (ht & 3)) * 32;
        const float* kb = ck + ((long)page * 128 + r0) * 512 + h * 64; const float* vb = cv + ((long)page * 128 + r0) * 512 + h * 64;
#pragma unroll
        for (int i = 0; i < 8; ++i) { kreg[i] = __builtin_nontemporal_load((const f32x4s*)(kb + i * 2048 + loff)); vreg[i] = __builtin_nontemporal_load((const f32x4s*)(vb + i * 2048 + loff)); } };
    issue(0);
    for (int ht = 0; ht < 32; ++ht) {
#pragma unroll
        for (int i = 0; i < 8; ++i) { const int row = 8 * (i & 3) + 4 * (i >> 2) + lrow;
            *(__attribute__((address_space(3))) u32x2s*)(kimg + kwoff + row * 16) = (u32x2s){cvtpk(kreg[i][0], kreg[i][1]), cvtpk(kreg[i][2], kreg[i][3])};
            *(__attribute__((address_space(3))) u32x2s*)(vimg + vwoff + row * 64) = (u32x2s){cvtpk(vreg[i][0], vreg[i][1]), cvtpk(vreg[i][2], vreg[i][3])}; }
        if (ht + 1 < 32) issue(ht + 1);
        f32x16 p0;
#pragma unroll
        for (int d0 = 0; d0 < 4; ++d0) { const bf16x8 kf = *(const __attribute__((address_space(3))) bf16x8*)(kp0 + d0 * 1024);
            p0 = __builtin_amdgcn_mfma_f32_32x32x16_bf16(kf, qr[d0], d0 == 0 ? zc : p0, 0, 0, 0); }
        u32x4 w0, w1;
        Dc = sb_block(p0, Dc, hi != 0, Eb, w0, w1);
#pragma unroll
        for (int d0 = 0; d0 < 2; ++d0) { s16x4 lo[2], hh[2];
#pragma unroll
            for (int ks = 0; ks < 2; ++ks) { lo[ks] = vtr(vp0 + d0 * 2048 + ks * 1024); hh[ks] = vtr(vp0 + d0 * 2048 + ks * 1024 + 512); }
            o[d0] = __builtin_amdgcn_mfma_f32_32x32x16_bf16(__builtin_bit_cast(bf16x8, w0), (bf16x8){lo[0][0], lo[0][1], lo[0][2], lo[0][3], hh[0][0], hh[0][1], hh[0][2], hh[0][3]}, o[d0], 0, 0, 0);
            o[d0] = __builtin_amdgcn_mfma_f32_32x32x16_bf16(__builtin_bit_cast(bf16x8, w1), (bf16x8){lo[1][0], lo[1][1], lo[1][2], lo[1][3], hh[1][0], hh[1][1], hh[1][2], hh[1][3]}, o[d0], 0, 0, 0); }
        asm volatile("" ::: "memory");
    }
    const long pb = ((long)((b * 8 + h) * 8) ) * 8 + g;
#pragma unroll
    for (int r = 0; r < 4; ++r) { const int q = r + 4 * hi;
#pragma unroll
        for (int d0 = 0; d0 < 2; ++d0) PO[(pb + (long)q * 8) * 64 + d0 * 32 + r32] = o[d0][r]; }
    if (hi == 0 && r32 < 8) PT[pb + (long)r32 * 8] = Dc;
}
}
constexpr int NWAVES = 8;
#ifndef GEMM_ALIGN
#define GEMM_ALIGN true
#endif
#ifndef GEMM_SP2
#define GEMM_SP2 true
#endif
constexpr int DM = 1024, SEQ = 8192, NB = 2, MP = NB * SEQ, DB = 32, DL = 8, MS = DB * DL, MT = MP + MS;
constexpr int DCONV = 512, NH = 8, HD = 64, DATT = 512, DFF = 4096, DIN = 5120, PAGE = 128, NPAGES = 64;
constexpr float RMS_EPS = 1e-6f, LOG2E = 1.4426950408889634f, C2 = 0.125f * LOG2E;
using pg8::OFF_Y; using pg8::OFF_KP; using pg8::OFF_VP; using pg8::OFF_CP; using pg8::OFF_KS; using pg8::OFF_VS; using pg8::OFF_CS;
constexpr size_t OUT_ELEMS = 34113536;

constexpr size_t MiB = 1u << 20;
constexpr size_t WS_CTL = 0, CTL_ZERO_BYTES = 1 * MiB;
constexpr size_t WS_WIN = 2 * MiB, WS_WPC = 12 * MiB, WS_WPA = 13 * MiB, WS_WOUT = 14 * MiB, WS_WUP = 16 * MiB, WS_WDN = 24 * MiB;
constexpr size_t WS_H = 32 * MiB;
constexpr size_t WS_CU = 66 * MiB;
constexpr size_t WS_BG = 84 * MiB;
constexpr size_t WS_Q = 102 * MiB, WS_K = 120 * MiB, WS_V = 138 * MiB;
constexpr size_t WS_SGC = 156 * MiB, WS_SGA = 190 * MiB;
constexpr size_t WS_BC = 224 * MiB;
constexpr size_t WS_O = 242 * MiB;
constexpr size_t WS_T1 = 260 * MiB;
constexpr size_t WS_MG = 294 * MiB;
constexpr size_t WS_X1 = 328 * MiB;
constexpr size_t WS_G = 394 * MiB;
constexpr size_t WS_PT = 526 * MiB;
constexpr size_t WS_PO = 527 * MiB;
constexpr size_t WS_CGS = 560 * MiB, WS_US = 561 * MiB;
constexpr size_t WS_END = 562 * MiB;
constexpr int CW_BAR = 4096;
static_assert(WS_Q - WS_BG == 18 * MiB && WS_K - WS_Q == 18 * MiB && WS_V - WS_K == 18 * MiB, "EpiProj addresses BG|Q|K|V by stride");

constexpr int RING_OFF = 0, RING_BYTES = 131072;
constexpr int LDSCTL_OFF = RING_BYTES, MISC_OFF = LDSCTL_OFF + 320;
constexpr int LDS_BYTES = 147456;

struct Args {
    const float *xp, *xs, *ck, *cv, *sc; const int* pt; const float *n1w, *win, *cw, *wpc, *wpa, *ab, *wout, *n2w, *wup, *wdn, *nfw;
    float* out; unsigned char* ws; int ph_lo, ph_hi;
};
struct Frame {
    LAS unsigned char* lds; volatile LAS unsigned* MISC; gu32* ctl;
    int tid, lane, wave, vcu, G;
};

__device__ __forceinline__ float wave_sum(float v) {
#pragma unroll
    for (int o = 1; o < 64; o <<= 1) v += __shfl_xor(v, o);
    return v;
}
__device__ __forceinline__ int win_src_col(int vc) {
    const int u = vc >> 8, r = vc & 255;
    if (u < 4) return (r < 128) ? 512 + 128 * u + r : 1024 + 128 * u + (r - 128);
    if (u < 6) return 256 * (u - 4) + r;
    if (u < 12) return 1536 + 256 * (u - 6) + r;
    return 3072 + 256 * (u - 12) + r;
}
__device__ __forceinline__ void transpose_item(const float* W, int K, int N, bf16* WT, LAS float* scr, int kb, int nb, int src_n0, int lane) {
    const int k0 = 64 * kb, n0 = 32 * nb;
#pragma unroll 8
    for (int i = 0; i < 32; ++i) { const int kk = 2 * i + (lane >> 5); scr[kk * 33 + (lane & 31)] = W[(size_t)(k0 + kk) * N + src_n0 + (lane & 31)]; }
    LDS_WAIT(); asm volatile("" ::: "memory");
    const int c = lane & 7;
#pragma unroll
    for (int j = 0; j < 4; ++j) { const int n = (lane >> 3) + 8 * j; const LAS float* s = scr + (8 * c) * 33 + n;
        v4u o; o.x = pk2(s[0 * 33], s[1 * 33]); o.y = pk2(s[2 * 33], s[3 * 33]); o.z = pk2(s[4 * 33], s[5 * 33]); o.w = pk2(s[6 * 33], s[7 * 33]);
        *(GAS v4u*)(WT + (size_t)(n0 + n) * K + k0 + 8 * c) = o; }
    LDS_WAIT(); asm volatile("" ::: "memory");
}
__device__ __forceinline__ void rms_row_to_bf16(int lane, const float* xrow, const float* w, bf16* orow) {
    const GAS f32x4* xr = (const GAS f32x4*)xrow + lane; const GAS f32x4* wr = (const GAS f32x4*)w + lane;
    f32x4 v[4]; float s = 0.f;
#pragma unroll
    for (int j = 0; j < 4; ++j) { v[j] = xr[64 * j]; s += (v[j].x * v[j].x + v[j].y * v[j].y) + (v[j].z * v[j].z + v[j].w * v[j].w); }
    const float rstd = 1.0f / sqrtf(wave_sum(s) * (1.f / DM) + RMS_EPS);
    GAS unsigned long long* o8 = (GAS unsigned long long*)orow + lane;
#pragma unroll
    for (int j = 0; j < 4; ++j) { const f32x4 g = wr[64 * j]; o8[64 * j] = (unsigned long long)pk2(v[j].x * rstd * g.x, v[j].y * rstd * g.y) | ((unsigned long long)pk2(v[j].z * rstd * g.z, v[j].w * rstd * g.w) << 32); }
}
__device__ __forceinline__ void rms_row_to_f32(int lane, const float* xrow, const float* w, float* orow, bool poison) {
    const GAS f32x4* xr = (const GAS f32x4*)xrow + lane; const GAS f32x4* wr = (const GAS f32x4*)w + lane;
    f32x4 v[4]; float s = 0.f;
#pragma unroll
    for (int j = 0; j < 4; ++j) { v[j] = xr[64 * j]; s += (v[j].x * v[j].x + v[j].y * v[j].y) + (v[j].z * v[j].z + v[j].w * v[j].w); }
    float rstd = 1.0f / sqrtf(wave_sum(s) * (1.f / DM) + RMS_EPS); if (poison) rstd = __builtin_nanf("");
    GAS f32x4* o = (GAS f32x4*)orow + lane;
#pragma unroll
    for (int j = 0; j < 4; ++j) { const f32x4 g = wr[64 * j]; o[64 * j] = v[j] * rstd * g; }
}
__device__ __forceinline__ float bf2f(unsigned short b) { return __uint_as_float((unsigned)b << 16); }


typedef float f32x16m __attribute__((ext_vector_type(16)));
template <class Epi> __device__ __forceinline__ void skinny_gemm(const bf16* A, const bf16* Bt, int N, int K, const Epi& E, LAS unsigned char* ldsb, int first, int stride) {
    const int tid = threadIdx.x, lane = tid & 63, r32 = lane & 31, hi = lane >> 5; const int wid = __builtin_amdgcn_readfirstlane(tid >> 6);
    const int ntiles = 8 * (N >> 5), kw = K >> 3, k0 = wid * kw;
    LAS float* red = (LAS float*)ldsb;
    for (int tl = first; tl < ntiles; tl += stride) {
        const int row0 = (tl & 7) * 32, col0 = (tl >> 3) * 32;
        const bf16* ap = A + (size_t)(row0 + r32) * K + k0 + 8 * hi; const bf16* bp = Bt + (size_t)(col0 + r32) * K + k0 + 8 * hi;
        f32x16m acc = {};
#pragma unroll 8
        for (int k = 0; k < kw; k += 16) { const bf16x8 a = *(const bf16x8*)(ap + k), b = *(const bf16x8*)(bp + k); acc = __builtin_amdgcn_mfma_f32_32x32x16_bf16(a, b, acc, 0, 0, 0); }
#pragma unroll
        for (int r = 0; r < 16; ++r) red[(wid * 16 + r) * 64 + lane] = acc[r];
        __syncthreads();
#pragma unroll
        for (int h2 = 0; h2 < 2; ++h2) { const int rr = wid + 8 * h2; float sum = 0.f;
#pragma unroll
            for (int w = 0; w < 8; ++w) sum += red[(w * 16 + rr) * 64 + lane];
            E(row0 + (rr & 3) + 8 * (rr >> 2) + 4 * hi, col0 + r32, sum); }
        __syncthreads();
    }
}
struct SkProj {
    float *CGs, *Us; bf16 *BG, *SGC, *SGA; float* out; float qscale;
    __device__ __forceinline__ void operator()(int srow, int vc, float v) const {
        const int u = vc >> 8, r = vc & 255; const size_t row = (size_t)MP + srow;
        if (u < 4) { if (r < 128) CGs[srow * 512 + 128 * u + r] = v; else Us[srow * 512 + 128 * u + r - 128] = v; }
        else if (u < 12) { const int kind = (u - 4) >> 1, col = ((u - 4) & 1) * 256 + r; if (kind == 1) v *= qscale;
            (BG + (size_t)kind * (size_t)(18u << 19))[row * 512 + col] = (bf16)f2bf(v);
            if (kind == 2) out[OFF_KS + (size_t)srow * 512 + col] = v; if (kind == 3) out[OFF_VS + (size_t)srow * 512 + col] = v; }
        else { bf16* dst = u < 16 ? SGC : SGA; const int col = ((u - 12) & 3) * 256 + r; dst[row * 1024 + col] = (bf16)f2bf(pg8::sigmoidf_fast(v)); }
    }
};
template <int MODE> struct SkBf {
    bf16* O; int ldc; const bf16* G1; const bf16* ADD;
    __device__ __forceinline__ void operator()(int srow, int col, float v) const { const size_t i = (size_t)srow * ldc + col;
        if (MODE == 0 || MODE == 1) v *= bf2f(G1[i]); if (MODE == 1) v += bf2f(ADD[i]); if (MODE == 2) { v = fmaxf(v, 0.f); v *= v; }
        O[i] = (bf16)f2bf(v); }
};
struct SkRes {
    const float* base; float* out;
    __device__ __forceinline__ void operator()(int srow, int col, float v) const { const size_t i = (size_t)srow * 1024 + col; out[i] = base[i] + v; }
};

__global__ void __launch_bounds__(NWAVES * 64, 2) hybrid_fwd(Args args) {
    extern __shared__ __attribute__((aligned(16))) unsigned char lds[];
    Frame F;
    F.lds = (LAS unsigned char*)lds;
    F.MISC = (volatile LAS unsigned*)(F.lds + MISC_OFF);
    F.tid = threadIdx.x; F.lane = F.tid & 63; F.wave = __builtin_amdgcn_readfirstlane(F.tid >> 6);
    F.G = gridDim.x; { const int bx = blockIdx.x; F.vcu = (F.G % 8 == 0) ? (bx % 8) * (F.G / 8) + bx / 8 : bx; }
    unsigned char* ws = args.ws;
    F.ctl = (gu32*)(ws + WS_CTL);
    bf16* const Win_t = (bf16*)(ws + WS_WIN); bf16* const Wpc_t = (bf16*)(ws + WS_WPC); bf16* const Wpa_t = (bf16*)(ws + WS_WPA);
    bf16* const Wout_t = (bf16*)(ws + WS_WOUT); bf16* const Wup_t = (bf16*)(ws + WS_WUP); bf16* const Wdn_t = (bf16*)(ws + WS_WDN);
    bf16* const HB = (bf16*)(ws + WS_H); bf16* const CUB = (bf16*)(ws + WS_CU); bf16* const BGB = (bf16*)(ws + WS_BG);
    bf16* const QB = (bf16*)(ws + WS_Q); bf16* const KB = (bf16*)(ws + WS_K); bf16* const VB = (bf16*)(ws + WS_V);
    bf16* const SGC = (bf16*)(ws + WS_SGC); bf16* const SGA = (bf16*)(ws + WS_SGA); bf16* const BCB = (bf16*)(ws + WS_BC); bf16* const OB = (bf16*)(ws + WS_O);
    bf16* const T1 = (bf16*)(ws + WS_T1); bf16* const MG = (bf16*)(ws + WS_MG); float* const X1 = (float*)(ws + WS_X1); bf16* const GB = (bf16*)(ws + WS_G);
    float* const PT = (float*)(ws + WS_PT); float* const PO = (float*)(ws + WS_PO); float* const CGs = (float*)(ws + WS_CGS); float* const Us = (float*)(ws + WS_US);
    for (int u = F.tid; u < (LDS_BYTES - LDSCTL_OFF) / 4; u += NWAVES * 64) ((LAS unsigned*)(F.lds + LDSCTL_OFF))[u] = 0u;
    __syncthreads();
    XcdBarrier bar = xcd_barrier_post((unsigned*)(F.ctl + CW_BAR), F.MISC + 8);
    const int gw = F.vcu * NWAVES + F.wave, NGW = F.G * NWAVES;
    const int gtid = blockIdx.x * (NWAVES * 64) + F.tid, NGT = F.G * NWAVES * 64;

    const int lo = args.ph_lo, hi = args.ph_hi;
#define IN(k) (lo <= (k) && (k) < hi)
#define SEAM(k) do { if (IN(k) && IN((k) + 1)) xcd_barrier(bar); } while (0)
    if (IN(0)) {
        LAS float* scr = (LAS float*)(F.lds + RING_OFF + F.wave * 16384);
        constexpr int I_IN = (DM / 64) * (DIN / 32), I_PC = (DCONV / 64) * (DM / 32), I_PA = (DATT / 64) * (DM / 32), I_OUT = (DM / 64) * (DM / 32), I_UP = (DM / 64) * (DFF / 32), I_DN = (DFF / 64) * (DM / 32);
        constexpr int NITEMS = I_IN + I_PC + I_PA + I_OUT + I_UP + I_DN;
        for (int it = gw; it < NITEMS; it += NGW) {
            int r = it;
            if (r < I_IN) { const int nblk = DIN / 32, kb = r / nblk, nb = r % nblk; transpose_item(args.win, DM, DIN, Win_t, scr, kb, nb, win_src_col(32 * nb), F.lane); continue; } r -= I_IN;
            if (r < I_PC) { const int nblk = DM / 32, kb = r / nblk, nb = r % nblk; transpose_item(args.wpc, DCONV, DM, Wpc_t, scr, kb, nb, 32 * nb, F.lane); continue; } r -= I_PC;
            if (r < I_PA) { const int nblk = DM / 32, kb = r / nblk, nb = r % nblk; transpose_item(args.wpa, DATT, DM, Wpa_t, scr, kb, nb, 32 * nb, F.lane); continue; } r -= I_PA;
            if (r < I_OUT) { const int nblk = DM / 32, kb = r / nblk, nb = r % nblk; transpose_item(args.wout, DM, DM, Wout_t, scr, kb, nb, 32 * nb, F.lane); continue; } r -= I_OUT;
            if (r < I_UP) { const int nblk = DFF / 32, kb = r / nblk, nb = r % nblk; transpose_item(args.wup, DM, DFF, Wup_t, scr, kb, nb, 32 * nb, F.lane); continue; } r -= I_UP;
            { const int nblk = DM / 32, kb = r / nblk, nb = r % nblk; transpose_item(args.wdn, DFF, DM, Wdn_t, scr, kb, nb, 32 * nb, F.lane); }
        }
        for (int m = gw; m < MT; m += NGW) rms_row_to_bf16(F.lane, m < MP ? args.xp + (size_t)m * DM : args.xs + (size_t)(m - MP) * DM, args.n1w, HB + (size_t)m * DM);
    }
    SEAM(0);

    if (IN(1)) {
        { SkProj E{CGs, Us, BGB, SGC, SGA, args.out, C2}; skinny_gemm(HB + (size_t)MP * DM, Win_t, DIN, DM, E, F.lds + RING_OFF, F.vcu, F.G); }
        pg8::Gemm g{HB, Win_t, MP, DIN, DM}; pg8::StaticOrder S; S.init(MP, DIN, F.G, (int)blockIdx.x);
        pg8::EpiProj E{CUB, BGB, QB, KB, VB, SGC, SGA, args.out, C2};
        pg8::gemm_phase<pg8::EpiProj, pg8::StaticOrder, GEMM_ALIGN, GEMM_SP2>(F.lds + RING_OFF, g, S, E);
    }
    SEAM(1);

    if (IN(2)) {
        for (int it = gtid; it < MP * 64; it += NGT) {
            const int row = it >> 6, j = (it & 63) * 8, t = row & (SEQ - 1);
            f32x4 c0a, c0b, c1a, c1b, c2a, c2b, ba, bb; const f32x4 z4 = {0.f, 0.f, 0.f, 0.f};
            pg8::unpack8(*(const pg8::u32x4*)(CUB + (size_t)row * 512 + j), c2a, c2b);
            pg8::unpack8(*(const pg8::u32x4*)(BGB + (size_t)row * 512 + j), ba, bb);
            if (t >= 1) pg8::unpack8(*(const pg8::u32x4*)(CUB + (size_t)(row - 1) * 512 + j), c1a, c1b); else { c1a = z4; c1b = z4; }
            if (t >= 2) pg8::unpack8(*(const pg8::u32x4*)(CUB + (size_t)(row - 2) * 512 + j), c0a, c0b); else { c0a = z4; c0b = z4; }
            const f32x4 w0a = *(const f32x4*)(args.cw + j), w0b = *(const f32x4*)(args.cw + j + 4), w1a = *(const f32x4*)(args.cw + 512 + j), w1b = *(const f32x4*)(args.cw + 512 + j + 4),
                        w2a = *(const f32x4*)(args.cw + 1024 + j), w2b = *(const f32x4*)(args.cw + 1024 + j + 4);
            const f32x4 ra = ba * (w0a * c0a + w1a * c1a + w2a * c2a), rb = bb * (w0b * c0b + w1b * c1b + w2b * c2b);
            *(pg8::u32x4*)(BCB + (size_t)row * 512 + j) = pg8::pack8(ra, rb);
        }
        for (int it = gtid; it < MS * 64; it += NGT) {
            const int r = it >> 6, j = (it & 63) * 8, t = r & 7; const float* st = args.sc + (size_t)(r >> 3) * 2 * 512 + j;
            const float* cg = CGs + (size_t)r * 512 + j; const float* uu = Us + (size_t)r * 512 + j;
            const f32x4 c2a = *(const f32x4*)cg * *(const f32x4*)uu, c2b = *(const f32x4*)(cg + 4) * *(const f32x4*)(uu + 4);
            f32x4 c1a, c1b, c0a, c0b, ba, bb;
            if (t >= 1) { c1a = *(const f32x4*)(cg - 512) * *(const f32x4*)(uu - 512); c1b = *(const f32x4*)(cg - 508) * *(const f32x4*)(uu - 508); } else { c1a = *(const f32x4*)(st + 512); c1b = *(const f32x4*)(st + 516); }
            if (t >= 2) { c0a = *(const f32x4*)(cg - 1024) * *(const f32x4*)(uu - 1024); c0b = *(const f32x4*)(cg - 1020) * *(const f32x4*)(uu - 1020); }
            else { const float* s2 = st + (t == 1 ? 512 : 0); c0a = *(const f32x4*)s2; c0b = *(const f32x4*)(s2 + 4); }
            pg8::unpack8(*(const pg8::u32x4*)(BGB + ((size_t)MP + r) * 512 + j), ba, bb);
            const f32x4 w0a = *(const f32x4*)(args.cw + j), w0b = *(const f32x4*)(args.cw + j + 4), w1a = *(const f32x4*)(args.cw + 512 + j), w1b = *(const f32x4*)(args.cw + 512 + j + 4),
                        w2a = *(const f32x4*)(args.cw + 1024 + j), w2b = *(const f32x4*)(args.cw + 1024 + j + 4);
            const f32x4 ra = ba * (w0a * c0a + w1a * c1a + w2a * c2a), rb = bb * (w0b * c0b + w1b * c1b + w2b * c2b);
            *(pg8::u32x4*)(BCB + ((size_t)MP + r) * 512 + j) = pg8::pack8(ra, rb);
            if (t >= 6) { float* cs = args.out + OFF_CS + (size_t)(((r >> 3) * 2 + (t - 6)) * 512 + j); *(f32x4*)cs = c2a; *(f32x4*)(cs + 4) = c2b; }
        }
        for (int v = F.vcu; v < 256; v += F.G) {
            const int bh = v >> 4, sq = v & 15, opt = bh & 3; const float biasl = args.ab[bh & 7] * LOG2E;
            for (int seg = 0; seg < 3; ++seg) {
                const bool smp = (seg == 0 && opt == 0) || (seg == 1 && (opt == 1 || opt == 2)) || (seg == 2 && opt == 3);
                if (smp) { sba::sample_group(v >> 3, v & 7, QB, args.ck, args.cv, args.pt, args.ab[F.wave] * LOG2E, PT, PO, (char*)lds + RING_OFF, MP); __syncthreads(); }
                if (seg < 2) { const int qb = ((seg == 0) == (opt == 1)) ? sq : 31 - sq;
                    sba::unit(bh >> 3, bh & 7, qb, QB, KB, VB, OB, biasl, (char*)lds + RING_OFF); }
            }
        }
    }
    SEAM(2);

    if (IN(3)) {
        for (int item = gtid; item < MS * 8 * 64; item += NGT) {
            const int d = item & 63, i = (item >> 6) & 7, h = (item >> 9) & 7, b = item >> 12;
            const size_t qrow = (size_t)MP + b * 8 + i;
            float Dp = 1.0f, acc = 0.f; const float biasl = args.ab[h] * LOG2E;
            for (int jn = i - 1; jn >= 0; --jn) {
                const size_t krow = (size_t)MP + b * 8 + jn; float dot = 0.f;
                for (int dd = 0; dd < 64; ++dd) dot += bf2f(QB[qrow * 512 + h * 64 + dd]) * bf2f(KB[krow * 512 + h * 64 + dd]);
                const float e = __builtin_amdgcn_exp2f(dot + biasl);
                Dp *= (1.0f + e);
                acc += e * __builtin_amdgcn_rcpf(Dp) * bf2f(VB[krow * 512 + h * 64 + d]);
            }
            const size_t pbase = ((size_t)((b * 8 + h) * 8 + i)) * 8;
            for (int j = 7; j >= 0; --j) { acc += PO[(pbase + j) * 64 + d] * __builtin_amdgcn_rcpf(Dp); Dp *= PT[pbase + j]; }
            OB[qrow * 512 + h * 64 + d] = (bf16)f2bf(acc);
        }
        { SkBf<0> E{T1 + (size_t)MP * DM, DM, SGC + (size_t)MP * DM, nullptr}; skinny_gemm(BCB + (size_t)MP * DCONV, Wpc_t, DM, DCONV, E, F.lds + RING_OFF, F.vcu, F.G); }
        pg8::Gemm g{BCB, Wpc_t, MP, DM, DCONV}; pg8::StaticOrder S; S.init(MP, DM, F.G, (int)blockIdx.x);
        pg8::EpiBf<0> E{T1, DM, SGC, nullptr};
        pg8::gemm_phase<pg8::EpiBf<0>, pg8::StaticOrder, GEMM_ALIGN, GEMM_SP2>(F.lds + RING_OFF, g, S, E);
    }
    SEAM(3);

    if (IN(4)) {
        { SkBf<1> E{MG + (size_t)MP * DM, DM, SGA + (size_t)MP * DM, T1 + (size_t)MP * DM}; skinny_gemm(OB + (size_t)MP * DATT, Wpa_t, DM, DATT, E, F.lds + RING_OFF, F.vcu, F.G); }
        pg8::Gemm g{OB, Wpa_t, MP, DM, DATT}; pg8::StaticOrder S; S.init(MP, DM, F.G, (int)blockIdx.x);
        pg8::EpiBf<1> E{MG, DM, SGA, T1};
        pg8::gemm_phase<pg8::EpiBf<1>, pg8::StaticOrder, GEMM_ALIGN, GEMM_SP2>(F.lds + RING_OFF, g, S, E);
    }
    SEAM(4);

    if (IN(5)) {
        { SkRes E{args.xs, X1 + (size_t)MP * DM}; skinny_gemm(MG + (size_t)MP * DM, Wout_t, DM, DM, E, F.lds + RING_OFF, F.vcu, F.G); }
        pg8::Gemm g{MG, Wout_t, MP, DM, DM}; pg8::StaticOrder S; S.init(MP, DM, F.G, (int)blockIdx.x);
        pg8::EpiResF32 E{args.xp, args.xs, X1};
        pg8::gemm_phase<pg8::EpiResF32, pg8::StaticOrder, GEMM_ALIGN, GEMM_SP2>(F.lds + RING_OFF, g, S, E);
    }
    SEAM(5);

    if (IN(6)) for (int m = gw; m < MT; m += NGW) rms_row_to_bf16(F.lane, X1 + (size_t)m * DM, args.n2w, HB + (size_t)m * DM);
    SEAM(6);

    if (IN(7)) {
        { SkBf<2> E{GB + (size_t)MP * DFF, DFF, nullptr, nullptr}; skinny_gemm(HB + (size_t)MP * DM, Wup_t, DFF, DM, E, F.lds + RING_OFF, F.vcu, F.G); }
        pg8::Gemm g{HB, Wup_t, MP, DFF, DM}; pg8::StaticOrder S; S.init(MP, DFF, F.G, (int)blockIdx.x);
        pg8::EpiBf<2> E{GB, DFF, nullptr, nullptr};
        pg8::gemm_phase<pg8::EpiBf<2>, pg8::StaticOrder, GEMM_ALIGN, GEMM_SP2>(F.lds + RING_OFF, g, S, E);
    }
    SEAM(7);

    if (IN(8)) {
        { SkRes E{X1 + (size_t)MP * DM, args.out + OFF_Y + (size_t)MP * DM}; skinny_gemm(GB + (size_t)MP * DFF, Wdn_t, DM, DFF, E, F.lds + RING_OFF, F.vcu, F.G); }
        pg8::Gemm g{GB, Wdn_t, MP, DM, DFF}; pg8::StaticOrder S; S.init(MP, DM, F.G, (int)blockIdx.x);
        pg8::EpiResF32 E{X1, X1 + (size_t)MP * DM, args.out + OFF_Y};
        pg8::gemm_phase<pg8::EpiResF32, pg8::StaticOrder, GEMM_ALIGN, GEMM_SP2>(F.lds + RING_OFF, g, S, E);
    }
    SEAM(8);

    if (IN(9)) {
    const bool poison = __hip_atomic_load((gu32*)((unsigned*)(F.ctl + CW_BAR) + XB_TMO), RLX_AGENT) != 0u;
    for (int m = gw; m < MT; m += NGW) rms_row_to_f32(F.lane, args.out + OFF_Y + (size_t)m * DM, args.nfw, args.out + OFF_Y + (size_t)m * DM, poison);
    }
#undef IN
#undef SEAM
}

extern "C" void kernel_launch(void* const* d_in, const int* in_sizes, int n_in, void* d_out, int out_size, void* d_ws, size_t ws_size, hipStream_t stream) {
    static int grid = 0;
    if (grid == 0) {
        if (n_in != 17 || (size_t)out_size != OUT_ELEMS || ws_size < WS_END) { fprintf(stderr, "kernel_launch: unexpected problem shape (n_in %d out %d ws %zu)\n", n_in, out_size, ws_size); grid = -1; return; }
        int dev = 0, cus = 0, per_cu = 0;
        if (hipGetDevice(&dev) != hipSuccess || hipDeviceGetAttribute(&cus, hipDeviceAttributeMultiprocessorCount, dev) != hipSuccess) { grid = -1; return; }
        if (hipFuncSetAttribute((const void*)hybrid_fwd, hipFuncAttributeMaxDynamicSharedMemorySize, LDS_BYTES) != hipSuccess) { fprintf(stderr, "kernel_launch: hipFuncSetAttribute failed\n"); grid = -1; return; }
        if (hipOccupancyMaxActiveBlocksPerMultiprocessor(&per_cu, (const void*)hybrid_fwd, NWAVES * 64, LDS_BYTES) != hipSuccess || per_cu < 1) { fprintf(stderr, "kernel_launch: occupancy query says %d\n", per_cu); }
        (void)hipGetLastError();
        grid = cus;
    }
    if (grid < 0) return;
    if (hipMemsetAsync((char*)d_ws + WS_CTL, 0, CTL_ZERO_BYTES, stream) != hipSuccess) return;
    Args a{};
    a.xp = (const float*)d_in[0]; a.xs = (const float*)d_in[1]; a.ck = (const float*)d_in[2]; a.cv = (const float*)d_in[3]; a.sc = (const float*)d_in[4]; a.pt = (const int*)d_in[5];
    a.n1w = (const float*)d_in[6]; a.win = (const float*)d_in[7]; a.cw = (const float*)d_in[8]; a.wpc = (const float*)d_in[9]; a.wpa = (const float*)d_in[10]; a.ab = (const float*)d_in[11];
    a.wout = (const float*)d_in[12]; a.n2w = (const float*)d_in[13]; a.wup = (const float*)d_in[14]; a.wdn = (const float*)d_in[15]; a.nfw = (const float*)d_in[16];
    a.out = (float*)d_out; a.ws = (unsigned char*)d_ws;
    constexpr int NPH = 10;
#ifndef MK_PER_PHASE
#define MK_PER_PHASE 0
#endif
    if (MK_PER_PHASE) { for (int k = 0; k < NPH; ++k) { a.ph_lo = k; a.ph_hi = k + 1; hipLaunchKernelGGL(hybrid_fwd, dim3(grid), dim3(NWAVES * 64), LDS_BYTES, stream, a); } }
    else { a.ph_lo = 0; a.ph_hi = NPH; hipLaunchKernelGGL(hybrid_fwd, dim3(grid), dim3(NWAVES * 64), LDS_BYTES, stream, a); }
}
```
